# Optimizing an MI355X kernel written in HIP

```python
import math
import jax
import jax.numpy as jnp
from jax import lax
import numpy as np

D_MODEL = 1024
BATCH = 32
SEQ = 256
DEPTH = 2
DEC_BATCH = 4
DEC_SEQ = 1024
PAST_LEN = 256

GRID_W = 64
N_EVEN = (DEPTH + 1) // 2
N_ODD = DEPTH // 2
HEAD_DIM = 64
H_A = 8
QK_NOPE = 64
QK_ROPE = 32
V_A = 64
Q_LORA = 256
KV_LORA = 128
H_B = 4
DH_B = HEAD_DIM
H_C = 8
KV_C = 2
DH_C = HEAD_DIM
H_D = 8
DH_D = HEAD_DIM
NA_WIN_ROWS = 8
NA_WIN_COLS = 16
MIX_EVEN = H_A * V_A + H_B * 2 * DH_B
MIX_ODD = H_C * DH_C + H_D * DH_D
EVEN_SIZES = (Q_LORA, KV_LORA, QK_ROPE, H_B * 2 * DH_B, H_B * 2 * DH_B, H_B * 2 * DH_B)
ODD_SIZES = (H_C * DH_C, KV_C * DH_C, KV_C * DH_C, H_D * DH_D, H_D * DH_D, H_D * DH_D)
D_FF = 2816
CONV_WIDTH = 3
Q_BLOCK = 128
ROPE_THETA = 10000.0
EPS = 1e-6
NEG_INF = -1e30

kernel_name = "hybrid_mla_diff_gqa_natten_dit_step"


def rmsnorm(x, w):
    xf = x.astype(jnp.float32)
    y = xf * lax.rsqrt(jnp.mean(xf * xf, axis=-1, keepdims=True) + EPS)
    return (y * w.astype(jnp.float32)).astype(x.dtype)


def split_cols(z, sizes):
    return jnp.split(z, np.cumsum(sizes)[:-1].tolist(), axis=-1)


def adaln(cvec, w, b):
    m = jax.nn.silu(cvec) @ w + b
    return jnp.split(m, 6, axis=-1)


def modulate(x, shift, scale):
    return x * (1.0 + scale[:, None, :]) + shift[:, None, :]


def axial_rope_table(n_tokens, rot_dim):
    t = np.arange(n_tokens)
    n_freq = rot_dim // 4
    inv = 1.0 / (ROPE_THETA ** (np.arange(n_freq) / n_freq))
    ang = np.concatenate([(t // GRID_W)[:, None] * inv[None, :],
                          (t % GRID_W)[:, None] * inv[None, :]], axis=-1)
    return jnp.asarray(np.cos(ang), jnp.float32), jnp.asarray(np.sin(ang), jnp.float32)


def apply_rope(x, cos, sin):
    shape = (cos.shape[0],) + (1,) * (x.ndim - 3) + (cos.shape[1],)
    cos = cos.reshape(shape).astype(x.dtype)
    sin = sin.reshape(shape).astype(x.dtype)
    half = x.shape[-1] // 2
    x1, x2 = x[..., :half], x[..., half:]
    return jnp.concatenate([x1 * cos - x2 * sin, x1 * sin + x2 * cos], axis=-1)


def map_query_blocks(fn, q):
    b, s = q.shape[0], q.shape[1]
    nb = s // Q_BLOCK
    qb = jnp.moveaxis(q.reshape((b, nb, Q_BLOCK) + q.shape[2:]), 1, 0)
    out = jnp.moveaxis(lax.map(fn, qb), 0, 1)
    return out.reshape((b, s) + out.shape[3:])


def mla_attend(q, k_nope, k_pe, v):
    scale = (QK_NOPE + QK_ROPE) ** -0.5
    def block(qb):
        s = (jnp.einsum('bqhd,bthd->bhqt', qb[..., :QK_NOPE], k_nope)
             + jnp.einsum('bqhr,btr->bhqt', qb[..., QK_NOPE:], k_pe)).astype(jnp.float32) * scale
        p = jax.nn.softmax(s, axis=-1).astype(v.dtype)
        return jnp.einsum('bhqt,bthd->bqhd', p, v)
    return map_query_blocks(block, q)


def diff_attend(q, k, v, lam):
    scale = q.shape[-1] ** -0.5
    def block(qb):
        s = jnp.einsum('bqhcd,bthcd->bhcqt', qb, k).astype(jnp.float32) * scale
        p = jax.nn.softmax(s, axis=-1)
        a = (p[:, :, 0] - lam * p[:, :, 1]).astype(v.dtype)
        return jnp.einsum('bhqt,bthd->bqhd', a, v)
    return map_query_blocks(block, q)


def gqa_attend(q, k, v):
    scale = q.shape[-1] ** -0.5
    def block(qb):
        s = jnp.einsum('bqkgd,btkd->bkgqt', qb, k).astype(jnp.float32) * scale
        p = jax.nn.softmax(s, axis=-1).astype(v.dtype)
        return jnp.einsum('bkgqt,btkd->bqkgd', p, v)
    return map_query_blocks(block, q)


def neighbourhood_attend(q, k, v, k_ctx, v_ctx, rpb):
    b, s, h, dh = q.shape
    rows = s // GRID_W
    kr = min(NA_WIN_ROWS, rows)
    kc = NA_WIN_COLS
    r = np.arange(rows)
    rs = np.clip(r - kr // 2, 0, rows - kr)
    band = rs[:, None] + np.arange(kr)[None, :]
    col = np.arange(GRID_W)
    cs = np.clip(col - kc // 2, 0, GRID_W - kc)
    col_ok = (col[None, :] >= cs[:, None]) & (col[None, :] < cs[:, None] + kc)
    dr = band - r[:, None] + NA_WIN_ROWS - 1
    dc = np.clip(col[None, :] - col[:, None] + kc - 1, 0, 2 * kc - 2)
    bias = rpb[:, dr[:, None, :, None], dc[None, :, None, :]].astype(jnp.float32)
    scale = dh ** -0.5
    qg = q.reshape(b, rows, GRID_W, h, dh)
    kg = k.reshape(b, rows, GRID_W, h, dh)[:, band]
    vg = v.reshape(b, rows, GRID_W, h, dh)[:, band]
    s_loc = jnp.einsum('brqhd,brkwhd->bhrqkw', qg, kg).astype(jnp.float32) * scale + bias[None]
    s_loc = jnp.where(col_ok[None, None, None, :, None, :], s_loc, NEG_INF)
    s_ctx = jnp.einsum('brqhd,bthd->bhrqt', qg, k_ctx).astype(jnp.float32) * scale
    n_loc = kr * GRID_W
    sc = jnp.concatenate([s_loc.reshape(b, h, rows, GRID_W, n_loc), s_ctx], axis=-1)
    p = jax.nn.softmax(sc, axis=-1).astype(v.dtype)
    p_loc = p[..., :n_loc].reshape(b, h, rows, GRID_W, kr, GRID_W)
    p_ctx = p[..., n_loc:]
    out = (jnp.einsum('bhrqkw,brkwhd->brqhd', p_loc, vg)
           + jnp.einsum('bhrqt,bthd->brqhd', p_ctx, v_ctx))
    return out.reshape(b, s, h, dh)


def even_mixer(u, w_in, w_out, w_uq, q_norm_w, kv_norm_w, w_uk, w_uv, diff_lam, diff_subln_w,
               lam_init, ctx=None, rope=None):
    b, s, _ = u.shape
    cq, ckv, kpe, qd, kd, vd = split_cols(u @ w_in, EVEN_SIZES)
    q = (rmsnorm(cq, q_norm_w) @ w_uq).reshape(b, s, H_A, QK_NOPE + QK_ROPE)
    ckv = rmsnorm(ckv, kv_norm_w)
    qd = qd.reshape(b, s, H_B, 2, DH_B)
    kd = kd.reshape(b, s, H_B, 2 * DH_B)
    vd = vd.reshape(b, s, H_B, 2 * DH_B)
    state = (ckv, kpe, kd, vd)
    if ctx is None:
        ckv_all, kpe_all, kd_all, vd_all = state
    else:
        cos_a, sin_a, cos_h, sin_h = rope
        q = jnp.concatenate([q[..., :QK_NOPE], apply_rope(q[..., QK_NOPE:], cos_a, sin_a)], axis=-1)
        qd = apply_rope(qd, cos_h, sin_h)
        kd_rot = apply_rope(kd.reshape(b, s, H_B, 2, DH_B), cos_h, sin_h).reshape(b, s, H_B, 2 * DH_B)
        ckv_all = jnp.concatenate([ckv, ctx[0]], axis=1)
        kpe_all = jnp.concatenate([apply_rope(kpe, cos_a, sin_a), ctx[1]], axis=1)
        kd_all = jnp.concatenate([kd_rot, ctx[2]], axis=1)
        vd_all = jnp.concatenate([vd, ctx[3]], axis=1)
    t = ckv_all.shape[1]
    k_nope = (ckv_all @ w_uk).reshape(b, t, H_A, QK_NOPE)
    v_a = (ckv_all @ w_uv).reshape(b, t, H_A, V_A)
    o_a = mla_attend(q, k_nope, kpe_all, v_a)
    lf = diff_lam.astype(jnp.float32)
    lam = jnp.exp(jnp.sum(lf[0] * lf[1])) - jnp.exp(jnp.sum(lf[2] * lf[3])) + lam_init
    o_b = diff_attend(qd, kd_all.reshape(b, t, H_B, 2, DH_B), vd_all, lam)
    o_b = rmsnorm(o_b, diff_subln_w) * (1.0 - lam_init)
    o = jnp.concatenate([o_a.reshape(b, s, H_A * V_A), o_b.reshape(b, s, H_B * 2 * DH_B)], axis=-1)
    return o @ w_out, state


def odd_mixer(u, w_in, w_out, qk_norm_w, rpb, ctx=None, rope=None):
    b, s, _ = u.shape
    qc, kc, vc, qn, kn, vn = split_cols(u @ w_in, ODD_SIZES)
    qc = rmsnorm(qc.reshape(b, s, H_C, DH_C), qk_norm_w[0])
    kc = rmsnorm(kc.reshape(b, s, KV_C, DH_C), qk_norm_w[1])
    vc = vc.reshape(b, s, KV_C, DH_C)
    qn = qn.reshape(b, s, H_D, DH_D)
    kn = kn.reshape(b, s, H_D, DH_D)
    vn = vn.reshape(b, s, H_D, DH_D)
    state = (kc, vc, kn, vn)
    if ctx is None:
        o_c = gqa_attend(qc.reshape(b, s, KV_C, H_C // KV_C, DH_C), kc, vc)
        o_d = gqa_attend(qn[:, :, :, None], kn, vn)[:, :, :, 0]
    else:
        cos_h, sin_h = rope
        qc = apply_rope(qc, cos_h, sin_h)
        k_all = jnp.concatenate([apply_rope(kc, cos_h, sin_h), ctx[0]], axis=1)
        v_all = jnp.concatenate([vc, ctx[1]], axis=1)
        o_c = gqa_attend(qc.reshape(b, s, KV_C, H_C // KV_C, DH_C), k_all, v_all)
        o_d = neighbourhood_attend(qn, kn, vn, ctx[2], ctx[3], rpb)
    o = jnp.concatenate([o_c.reshape(b, s, H_C * DH_C), o_d.reshape(b, s, H_D * DH_D)], axis=-1)
    return o @ w_out, state


def conv_ffn(u, w_up, conv_w, conv_b, w_down):
    z = u @ w_up
    zp = jnp.pad(z, ((0, 0), (1, 1), (0, 0)))
    z = zp[:, :-2] * conv_w[0] + zp[:, 1:-1] * conv_w[1] + zp[:, 2:] * conv_w[2] + conv_b
    gate, val = jnp.split(z, 2, axis=-1)
    return (jax.nn.silu(gate) * val) @ w_down


def setup_inputs(seed: int = 0) -> dict:
    key = jax.random.key(seed)
    ks = iter(jax.random.split(key, 40))

    def nrm(shape, scale=1.0):
        return jax.random.normal(next(ks), shape, jnp.float32) * scale

    def gain(shape):
        return 1.0 + nrm(shape, 0.05)

    return {
        "x_prompt": nrm((BATCH, SEQ, D_MODEL)),
        "x_sample": nrm((DEC_BATCH, DEC_SEQ, D_MODEL)),
        "c": nrm((DEC_BATCH, D_MODEL)),
        "cache_mla_ckv": nrm((DEC_BATCH, N_EVEN, PAST_LEN, KV_LORA)),
        "cache_mla_kpe": nrm((DEC_BATCH, N_EVEN, PAST_LEN, QK_ROPE)),
        "cache_diff_k": nrm((DEC_BATCH, N_EVEN, PAST_LEN, H_B, 2 * DH_B)),
        "cache_diff_v": nrm((DEC_BATCH, N_EVEN, PAST_LEN, H_B, 2 * DH_B)),
        "cache_gqa_k": nrm((DEC_BATCH, N_ODD, PAST_LEN, KV_C, DH_C)),
        "cache_gqa_v": nrm((DEC_BATCH, N_ODD, PAST_LEN, KV_C, DH_C)),
        "cache_na_k": nrm((DEC_BATCH, N_ODD, PAST_LEN, H_D, DH_D)),
        "cache_na_v": nrm((DEC_BATCH, N_ODD, PAST_LEN, H_D, DH_D)),
        "c_ctx": nrm((D_MODEL,)),
        "norm_w": gain((DEPTH, 4, D_MODEL)),
        "w_mod": nrm((DEPTH, D_MODEL, 6 * D_MODEL), 0.5 * D_MODEL ** -0.5),
        "b_mod": nrm((DEPTH, 6 * D_MODEL), 0.01),
        "w_in_even": nrm((N_EVEN, D_MODEL, sum(EVEN_SIZES)), D_MODEL ** -0.5),
        "w_out_even": nrm((N_EVEN, MIX_EVEN, D_MODEL), MIX_EVEN ** -0.5),
        "w_uq": nrm((N_EVEN, Q_LORA, H_A * (QK_NOPE + QK_ROPE)), Q_LORA ** -0.5),
        "q_norm_w": gain((N_EVEN, Q_LORA)),
        "kv_norm_w": gain((N_EVEN, KV_LORA)),
        "w_uk": nrm((N_EVEN, KV_LORA, H_A * QK_NOPE), KV_LORA ** -0.5),
        "w_uv": nrm((N_EVEN, KV_LORA, H_A * V_A), KV_LORA ** -0.5),
        "diff_lam": nrm((N_EVEN, 4, DH_B), 0.1),
        "diff_subln_w": gain((N_EVEN, 2 * DH_B)),
        "w_in_odd": nrm((N_ODD, D_MODEL, sum(ODD_SIZES)), D_MODEL ** -0.5),
        "w_out_odd": nrm((N_ODD, MIX_ODD, D_MODEL), MIX_ODD ** -0.5),
        "qk_norm_w": gain((N_ODD, 2, DH_C)),
        "na_rpb": nrm((N_ODD, H_D, 2 * NA_WIN_ROWS - 1, 2 * NA_WIN_COLS - 1), 0.1),
        "w_up": nrm((DEPTH, D_MODEL, 2 * D_FF), D_MODEL ** -0.5),
        "conv_w": nrm((DEPTH, CONV_WIDTH, 2 * D_FF), CONV_WIDTH ** -0.5),
        "conv_b": nrm((DEPTH, 2 * D_FF), 0.01),
        "w_down": nrm((DEPTH, D_FF, D_MODEL), D_FF ** -0.5),
    }


def reference(x_prompt, x_sample, c, cache_mla_ckv, cache_mla_kpe, cache_diff_k, cache_diff_v,
              cache_gqa_k, cache_gqa_v, cache_na_k, cache_na_v, c_ctx, norm_w, w_mod, b_mod,
              w_in_even, w_out_even, w_uq, q_norm_w, kv_norm_w, w_uk, w_uv, diff_lam, diff_subln_w,
              w_in_odd, w_out_odd, qk_norm_w, na_rpb, w_up, conv_w, conv_b, w_down):
    n_lat = x_sample.shape[1]
    cos_a, sin_a = axial_rope_table(n_lat, QK_ROPE)
    cos_h, sin_h = axial_rope_table(n_lat, HEAD_DIM)
    hp, hs = x_prompt, x_sample
    even_states, odd_states = [], []
    for l in range(DEPTH):
        mp = adaln(c_ctx[None, :], w_mod[l], b_mod[l])
        ms = adaln(c, w_mod[l], b_mod[l])
        up = modulate(rmsnorm(hp, norm_w[l, 0]), mp[0], mp[1])
        us = modulate(rmsnorm(hs, norm_w[l, 0]), ms[0], ms[1])
        i = l // 2
        if l % 2 == 0:
            lam_init = 0.8 - 0.6 * math.exp(-0.3 * l)
            args = (w_in_even[i], w_out_even[i], w_uq[i], q_norm_w[i], kv_norm_w[i], w_uk[i],
                    w_uv[i], diff_lam[i], diff_subln_w[i], lam_init)
            yp, st = even_mixer(up, *args)
            ys, _ = even_mixer(us, *args,
                               ctx=(cache_mla_ckv[:, i], cache_mla_kpe[:, i], cache_diff_k[:, i], cache_diff_v[:, i]),
                               rope=(cos_a, sin_a, cos_h, sin_h))
            even_states.append(st)
        else:
            args = (w_in_odd[i], w_out_odd[i], qk_norm_w[i], na_rpb[i])
            yp, st = odd_mixer(up, *args)
            ys, _ = odd_mixer(us, *args,
                              ctx=(cache_gqa_k[:, i], cache_gqa_v[:, i], cache_na_k[:, i], cache_na_v[:, i]),
                              rope=(cos_h, sin_h))
            odd_states.append(st)
        hp = hp + mp[2][:, None, :] * rmsnorm(yp, norm_w[l, 1])
        hs = hs + ms[2][:, None, :] * rmsnorm(ys, norm_w[l, 1])
        up = modulate(rmsnorm(hp, norm_w[l, 2]), mp[3], mp[4])
        us = modulate(rmsnorm(hs, norm_w[l, 2]), ms[3], ms[4])
        hp = hp + mp[5][:, None, :] * rmsnorm(conv_ffn(up, w_up[l], conv_w[l], conv_b[l], w_down[l]), norm_w[l, 3])
        hs = hs + ms[5][:, None, :] * rmsnorm(conv_ffn(us, w_up[l], conv_w[l], conv_b[l], w_down[l]), norm_w[l, 3])
    new_mla_ckv = jnp.stack([st[0] for st in even_states], axis=1)
    new_mla_kpe = jnp.stack([st[1] for st in even_states], axis=1)
    new_diff_k = jnp.stack([st[2] for st in even_states], axis=1)
    new_diff_v = jnp.stack([st[3] for st in even_states], axis=1)
    new_gqa_k = jnp.stack([st[0] for st in odd_states], axis=1)
    new_gqa_v = jnp.stack([st[1] for st in odd_states], axis=1)
    new_na_k = jnp.stack([st[2] for st in odd_states], axis=1)
    new_na_v = jnp.stack([st[3] for st in odd_states], axis=1)
    return (hp, hs, new_mla_ckv, new_mla_kpe, new_diff_k, new_diff_v, new_gqa_k, new_gqa_v, new_na_k, new_na_v)
```

```cpp
#include <hip/hip_runtime.h>
#include <cstdio>
#include <cstdint>
#include <cstring>

constexpr int D = 1024, NP = 8192, NS = 4096, NR = NP + NS;
constexpr int PAST = 256, DFF = 2816;
constexpr int NE = 1952, NO = 2304;
constexpr float EPS = 1e-6f;
constexpr int E_CQ = 0, E_CKV = 256, E_KPE = 384, E_QD = 416, E_KD = 928, E_VD = 1440;
constexpr int O_QC = 0, O_KC = 512, O_VC = 640, O_QN = 768, O_KN = 1280, O_VN = 1792;
constexpr size_t OUT_YP = 0, OUT_YS = (size_t)NP * D, OUT_CKV = (size_t)NR * D, OUT_KPE = OUT_CKV + (size_t)NP * 128, OUT_DK = OUT_KPE + (size_t)NP * 32,
                 OUT_DV = OUT_DK + (size_t)NP * 512, OUT_GK = OUT_DV + (size_t)NP * 512, OUT_GV = OUT_GK + (size_t)NP * 128, OUT_NK = OUT_GV + (size_t)NP * 128,
                 OUT_NV = OUT_NK + (size_t)NP * 512, OUT_END = OUT_NV + (size_t)NP * 512;

__device__ __forceinline__ int row_mod(int r) { return r < NP ? 0 : 1 + ((r - NP) >> 10); }
__device__ __forceinline__ float silu_f(float x) { return x / (1.f + expf(-x)); }

__global__ void __launch_bounds__(256) k_mod(const float* __restrict__ c, const float* __restrict__ c_ctx, const float* __restrict__ w_mod, const float* __restrict__ b_mod, float* __restrict__ mod) {
    __shared__ float sc[5][1024];
    const int l = blockIdx.y, n = blockIdx.x * 256 + threadIdx.x;
    for (int i = threadIdx.x; i < 5 * 1024; i += 256) { const int j = i >> 10, k = i & 1023; const float v = j == 0 ? c_ctx[k] : c[(j - 1) * 1024 + k]; sc[j][k] = silu_f(v); }
    __syncthreads();
    float acc[5] = {0.f, 0.f, 0.f, 0.f, 0.f};
    const float* w = w_mod + (size_t)l * 1024 * 6144 + n;
    for (int k = 0; k < 1024; ++k) { const float wv = w[(size_t)k * 6144];
#pragma unroll
        for (int j = 0; j < 5; ++j) acc[j] += sc[j][k] * wv; }
    const float b = b_mod[l * 6144 + n];
#pragma unroll
    for (int j = 0; j < 5; ++j) mod[((size_t)l * 5 + j) * 6144 + n] = acc[j] + b;
}

__device__ __forceinline__ float block_sum_256(float v, float* red) {
#pragma unroll
    for (int o = 32; o > 0; o >>= 1) v += __shfl_xor(v, o);
    __syncthreads();
    if ((threadIdx.x & 63) == 0) red[threadIdx.x >> 6] = v;
    __syncthreads();
    return red[0] + red[1] + red[2] + red[3];
}

__global__ void __launch_bounds__(256) k_normmod(const float* __restrict__ h, const float* __restrict__ nw, const float* __restrict__ modl, int shift_i, int scale_i, float* __restrict__ u) {
    __shared__ float red[4];
    const int r = blockIdx.x, j = row_mod(r);
    const float4 x = ((const float4*)(h + (size_t)r * D))[threadIdx.x];
    const float ss = block_sum_256(x.x * x.x + x.y * x.y + x.z * x.z + x.w * x.w, red);
    const float rstd = rsqrtf(ss * (1.f / D) + EPS);
    const float4 w = ((const float4*)nw)[threadIdx.x];
    const float4 sh = ((const float4*)(modl + (size_t)j * 6144 + shift_i * 1024))[threadIdx.x];
    const float4 sc = ((const float4*)(modl + (size_t)j * 6144 + scale_i * 1024))[threadIdx.x];
    float4 o; o.x = x.x * rstd * w.x * (1.f + sc.x) + sh.x; o.y = x.y * rstd * w.y * (1.f + sc.y) + sh.y; o.z = x.z * rstd * w.z * (1.f + sc.z) + sh.z; o.w = x.w * rstd * w.w * (1.f + sc.w) + sh.w;
    ((float4*)(u + (size_t)r * D))[threadIdx.x] = o;
}

__global__ void __launch_bounds__(256) k_resnorm(const float* hin, const float* __restrict__ y, const float* __restrict__ nw, const float* __restrict__ modl, int gate_i, float* hout) {
    __shared__ float red[4];
    const int r = blockIdx.x, j = row_mod(r);
    const float4 x = ((const float4*)(y + (size_t)r * D))[threadIdx.x];
    const float ss = block_sum_256(x.x * x.x + x.y * x.y + x.z * x.z + x.w * x.w, red);
    const float rstd = rsqrtf(ss * (1.f / D) + EPS);
    const float4 w = ((const float4*)nw)[threadIdx.x];
    const float4 g = ((const float4*)(modl + (size_t)j * 6144 + gate_i * 1024))[threadIdx.x];
    const float4 hi = ((const float4*)(hin + (size_t)r * D))[threadIdx.x];
    float4 o; o.x = hi.x + g.x * x.x * rstd * w.x; o.y = hi.y + g.y * x.y * rstd * w.y; o.z = hi.z + g.z * x.z * rstd * w.z; o.w = hi.w + g.w * x.w * rstd * w.w;
    ((float4*)(hout + (size_t)r * D))[threadIdx.x] = o;
}

__global__ void __launch_bounds__(256) k_gemm(const float* __restrict__ A, int lda, const float* __restrict__ B, int ldb, float* __restrict__ C, int ldc, int M, int N, int K) {
    __shared__ float As[16][68];
    __shared__ float Bs[16][68];
    const int tid = threadIdx.x, tx = tid & 15, ty = tid >> 4;
    const int m0 = blockIdx.y * 64, n0 = blockIdx.x * 64;
    float acc[4][4];
#pragma unroll
    for (int i = 0; i < 4; ++i)
#pragma unroll
        for (int j = 0; j < 4; ++j) acc[i][j] = 0.f;
    const int ar = tid >> 2, ac = (tid & 3) * 4;
    const int br = tid >> 4, bc = (tid & 15) * 4;
    for (int k0 = 0; k0 < K; k0 += 16) {
        const float4 av = *(const float4*)(A + (size_t)(m0 + ar) * lda + k0 + ac);
        float4 bv = make_float4(0.f, 0.f, 0.f, 0.f);
        if (n0 + bc < N) bv = *(const float4*)(B + (size_t)(k0 + br) * ldb + n0 + bc);
        __syncthreads();
        As[ac + 0][ar] = av.x; As[ac + 1][ar] = av.y; As[ac + 2][ar] = av.z; As[ac + 3][ar] = av.w;
        *(float4*)&Bs[br][bc] = bv;
        __syncthreads();
#pragma unroll
        for (int k = 0; k < 16; ++k) {
            const float4 a = *(const float4*)&As[k][ty * 4];
            const float4 b = *(const float4*)&Bs[k][tx * 4];
            const float aa[4] = {a.x, a.y, a.z, a.w}, bb[4] = {b.x, b.y, b.z, b.w};
#pragma unroll
            for (int i = 0; i < 4; ++i)
#pragma unroll
                for (int j = 0; j < 4; ++j) acc[i][j] += aa[i] * bb[j];
        }
    }
    if (n0 + tx * 4 < N) {
#pragma unroll
        for (int i = 0; i < 4; ++i) *(float4*)(C + (size_t)(m0 + ty * 4 + i) * ldc + n0 + tx * 4) = make_float4(acc[i][0], acc[i][1], acc[i][2], acc[i][3]);
    }
}

__device__ __forceinline__ void rope_angle(int t, int i, int rot_dim, float& cs, float& sn) {
    const int nf = rot_dim >> 2; const int fi = i < nf ? i : i - nf; const int p = i < nf ? (t >> 6) : (t & 63);
    const float inv = expf(-9.210340371976184f * (float)fi / (float)nf);
    const float a = (float)p * inv; cs = cosf(a); sn = sinf(a);
}
__device__ __forceinline__ void rope_pair(float* x, int t, int i, int rot_dim) {
    float cs, sn; rope_angle(t, i, rot_dim, cs, sn);
    const int half = rot_dim >> 1; const float x1 = x[i], x2 = x[i + half];
    x[i] = x1 * cs - x2 * sn; x[i + half] = x1 * sn + x2 * cs;
}

__global__ void __launch_bounds__(256) k_even_post(float* __restrict__ z, const float* __restrict__ qnw, const float* __restrict__ kvnw, float* __restrict__ cqn, float* __restrict__ ckvall, float* __restrict__ out) {
    __shared__ float red[4];
    const int r = blockIdx.x, tid = threadIdx.x;
    float* zr = z + (size_t)r * NE;
    const float v = zr[E_CQ + tid];
    const float ss = block_sum_256(v * v, red);
    cqn[(size_t)r * 256 + tid] = v * rsqrtf(ss * (1.f / 256.f) + EPS) * qnw[tid];
    const float kv = tid < 128 ? zr[E_CKV + tid] : 0.f;
    const float ss2 = block_sum_256(kv * kv, red);
    const float kvn = kv * rsqrtf(ss2 * (1.f / 128.f) + EPS) * (tid < 128 ? kvnw[tid] : 0.f);
    if (tid < 128) ckvall[(size_t)r * 128 + tid] = kvn;
    if (r < NP) {
        if (tid < 128) out[OUT_CKV + (size_t)r * 128 + tid] = kvn;
        if (tid < 32) out[OUT_KPE + (size_t)r * 32 + tid] = zr[E_KPE + tid];
        for (int i = tid; i < 512; i += 256) { out[OUT_DK + (size_t)r * 512 + i] = zr[E_KD + i]; out[OUT_DV + (size_t)r * 512 + i] = zr[E_VD + i]; }
    } else {
        const int t = (r - NP) & 1023;
        if (tid < 16) rope_pair(zr + E_KPE, t, tid, 32);
        { const int sh = tid >> 5, i = tid & 31; rope_pair(zr + E_QD + sh * 64, t, i, 64); rope_pair(zr + E_KD + sh * 64, t, i, 64); }
    }
}
__global__ void k_copy_cache_ckv(const float* __restrict__ cache, float* __restrict__ ckvall) {
    const int i = blockIdx.x * 256 + threadIdx.x;
    ckvall[(size_t)NR * 128 + i] = cache[i];
}
__global__ void __launch_bounds__(128) k_rope_q(float* __restrict__ q) {
    const int r = NP + blockIdx.x, t = blockIdx.x & 1023, h = threadIdx.x >> 4, i = threadIdx.x & 15;
    rope_pair(q + (size_t)r * 768 + h * 96 + 64, t, i, 32);
}

__global__ void __launch_bounds__(64) k_odd_post(float* __restrict__ z, const float* __restrict__ qknw, float* __restrict__ out) {
    const int r = blockIdx.x, lane = threadIdx.x;
    float* zr = z + (size_t)r * NO;
    const int t = r < NP ? 0 : ((r - NP) & 1023);
    float cs, sn; rope_angle(t, lane & 31, 64, cs, sn);
    for (int hh = 0; hh < 10; ++hh) {
        float* p = hh < 8 ? zr + O_QC + hh * 64 : zr + O_KC + (hh - 8) * 64;
        const float v = p[lane]; float ss = v * v;
#pragma unroll
        for (int o = 32; o > 0; o >>= 1) ss += __shfl_xor(ss, o);
        const float vn = v * rsqrtf(ss * (1.f / 64.f) + EPS) * qknw[(hh < 8 ? 0 : 64) + lane];
        if (r < NP) { p[lane] = vn; if (hh >= 8) out[OUT_GK + (size_t)r * 128 + (hh - 8) * 64 + lane] = vn; }
        else { const float other = __shfl_xor(vn, 32); p[lane] = lane < 32 ? vn * cs - other * sn : other * sn + vn * cs; }
    }
    if (r < NP) {
        for (int i = lane; i < 128; i += 64) out[OUT_GV + (size_t)r * 128 + i] = zr[O_VC + i];
        for (int i = lane; i < 512; i += 64) { out[OUT_NK + (size_t)r * 512 + i] = zr[O_KN + i]; out[OUT_NV + (size_t)r * 512 + i] = zr[O_VN + i]; }
    }
}

struct KeyRef { const float* ka[2]; const float* kb; const float* v; float bias; bool ok; };
constexpr int MAXK = 1280;

template <class P, bool LAM>
__global__ void __launch_bounds__(128) k_attn(P p, const float* __restrict__ lamp, float* __restrict__ o) {
    if (LAM) p.lam = lamp[0];
    __shared__ float q[2][64 + 32];
    __shared__ float s[P::C][MAXK];
    __shared__ float red[2];
    __shared__ float ov[128];
    const int r = p.row0 + blockIdx.x, h = blockIdx.y, tid = threadIdx.x;
#pragma unroll
    for (int c = 0; c < P::C; ++c) { if (tid < P::NA) q[c][tid] = p.qa(r, h, c)[tid]; }
    if (P::NB > 0 && tid < P::NB) q[0][P::NA + tid] = p.qb(r, h)[tid];
    __syncthreads();
    const int nk = p.nkeys(r);
    for (int t = tid; t < nk; t += 128) {
        KeyRef kr; p.key(r, h, t, kr);
#pragma unroll
        for (int c = 0; c < P::C; ++c) {
            float acc = -INFINITY;
            if (kr.ok) {
                acc = 0.f;
                for (int d = 0; d < P::NA; ++d) acc += q[c][d] * kr.ka[c][d];
                if (P::NB > 0) for (int d = 0; d < P::NB; ++d) acc += q[0][P::NA + d] * kr.kb[d];
                acc = acc * p.scale + kr.bias;
            }
            s[c][t] = acc;
        }
    }
    __syncthreads();
    float inv[P::C];
#pragma unroll
    for (int c = 0; c < P::C; ++c) {
        float m = -INFINITY;
        for (int t = tid; t < nk; t += 128) m = fmaxf(m, s[c][t]);
#pragma unroll
        for (int off = 32; off > 0; off >>= 1) m = fmaxf(m, __shfl_xor(m, off));
        __syncthreads();
        if ((tid & 63) == 0) red[tid >> 6] = m;
        __syncthreads();
        m = fmaxf(red[0], red[1]);
        float sum = 0.f;
        for (int t = tid; t < nk; t += 128) { const float e = expf(s[c][t] - m); s[c][t] = e; sum += e; }
#pragma unroll
        for (int off = 32; off > 0; off >>= 1) sum += __shfl_xor(sum, off);
        __syncthreads();
        if ((tid & 63) == 0) red[tid >> 6] = sum;
        __syncthreads();
        inv[c] = 1.f / (red[0] + red[1]);
    }
    __syncthreads();
    if (P::C == 2) { for (int t = tid; t < nk; t += 128) s[0][t] = s[0][t] * inv[0] - p.lam * s[1][t] * inv[1]; }
    else { for (int t = tid; t < nk; t += 128) s[0][t] = s[0][t] * inv[0]; }
    __syncthreads();
    constexpr int PARTS = 128 / P::DV;
    const int d = tid % P::DV, part = tid / P::DV;
    float acc = 0.f;
    for (int t = part; t < nk; t += PARTS) { const float a = s[0][t]; if (a != 0.f) { KeyRef kr; p.key(r, h, t, kr); acc += a * kr.v[d]; } }
    ov[tid] = acc;
    __syncthreads();
    if (PARTS == 2) { if (tid < 64) acc = ov[tid] + ov[tid + 64]; }
    if (P::SUBLN) {
        float ss = acc * acc;
#pragma unroll
        for (int off = 32; off > 0; off >>= 1) ss += __shfl_xor(ss, off);
        __syncthreads();
        if ((tid & 63) == 0) red[tid >> 6] = ss;
        __syncthreads();
        ss = red[0] + red[1];
        acc = acc * rsqrtf(ss * (1.f / 128.f) + EPS) * p.subln_w[tid] * p.post_scale;
    }
    if (tid < P::DV) o[(size_t)r * D + p.ocol(h) + tid] = acc;
}

struct PolMLA {
    static constexpr int C = 1, NA = 64, NB = 32, DV = 64; static constexpr bool SUBLN = false;
    int row0; const float* q; const float* kn; const float* kv; const float* z; const float* cache_kpe; float scale, lam; const float* subln_w; float post_scale;
    __device__ int nkeys(int r) const { return r < NP ? 256 : 1280; }
    __device__ const float* qa(int r, int h, int) const { return q + (size_t)r * 768 + h * 96; }
    __device__ const float* qb(int r, int h) const { return q + (size_t)r * 768 + h * 96 + 64; }
    __device__ int ocol(int h) const { return h * 64; }
    __device__ void key(int r, int h, int t, KeyRef& k) const {
        k.ok = true; k.bias = 0.f;
        if (r < NP) { const int rt = (r & ~255) + t; k.ka[0] = kn + (size_t)rt * 512 + h * 64; k.kb = z + (size_t)rt * NE + E_KPE; k.v = kv + (size_t)rt * 512 + h * 64; }
        else { const int b = (r - NP) >> 10;
            if (t < 1024) { const int rt = NP + b * 1024 + t; k.ka[0] = kn + (size_t)rt * 512 + h * 64; k.kb = z + (size_t)rt * NE + E_KPE; k.v = kv + (size_t)rt * 512 + h * 64; }
            else { const int rt = NR + b * 256 + (t - 1024); k.ka[0] = kn + (size_t)rt * 512 + h * 64; k.kb = cache_kpe + (size_t)(b * 256 + (t - 1024)) * 32; k.v = kv + (size_t)rt * 512 + h * 64; } }
        k.ka[1] = k.ka[0];
    }
};
struct PolDiff {
    static constexpr int C = 2, NA = 64, NB = 0, DV = 128; static constexpr bool SUBLN = true;
    int row0; const float* z; const float* cache_k; const float* cache_v; float scale, lam; const float* subln_w; float post_scale;
    __device__ int nkeys(int r) const { return r < NP ? 256 : 1280; }
    __device__ const float* qa(int r, int h, int c) const { return z + (size_t)r * NE + E_QD + h * 128 + c * 64; }
    __device__ const float* qb(int, int) const { return nullptr; }
    __device__ int ocol(int h) const { return 512 + h * 128; }
    __device__ void key(int r, int h, int t, KeyRef& k) const {
        k.ok = true; k.bias = 0.f; k.kb = nullptr;
        int rt = -1, ct = 0;
        if (r < NP) rt = (r & ~255) + t;
        else { const int b = (r - NP) >> 10; if (t < 1024) rt = NP + b * 1024 + t; else ct = b * 256 + (t - 1024); }
        if (rt >= 0) { k.ka[0] = z + (size_t)rt * NE + E_KD + h * 128; k.ka[1] = k.ka[0] + 64; k.v = z + (size_t)rt * NE + E_VD + h * 128; }
        else { k.ka[0] = cache_k + (size_t)ct * 512 + h * 128; k.ka[1] = k.ka[0] + 64; k.v = cache_v + (size_t)ct * 512 + h * 128; }
    }
};
struct PolGQA {
    static constexpr int C = 1, NA = 64, NB = 0, DV = 64; static constexpr bool SUBLN = false;
    int row0; const float* z; const float* cache_k; const float* cache_v; float scale, lam; const float* subln_w; float post_scale;
    __device__ int nkeys(int r) const { return r < NP ? 256 : 1280; }
    __device__ const float* qa(int r, int h, int) const { return z + (size_t)r * NO + O_QC + h * 64; }
    __device__ const float* qb(int, int) const { return nullptr; }
    __device__ int ocol(int h) const { return h * 64; }
    __device__ void key(int r, int h, int t, KeyRef& k) const {
        k.ok = true; k.bias = 0.f; k.kb = nullptr; const int kvh = h >> 2;
        int rt = -1, ct = 0;
        if (r < NP) rt = (r & ~255) + t;
        else { const int b = (r - NP) >> 10; if (t < 1024) rt = NP + b * 1024 + t; else ct = b * 256 + (t - 1024); }
        if (rt >= 0) { k.ka[0] = z + (size_t)rt * NO + O_KC + kvh * 64; k.v = z + (size_t)rt * NO + O_VC + kvh * 64; }
        else { k.ka[0] = cache_k + (size_t)ct * 128 + kvh * 64; k.v = cache_v + (size_t)ct * 128 + kvh * 64; }
        k.ka[1] = k.ka[0];
    }
};
struct PolNA {
    static constexpr int C = 1, NA = 64, NB = 0, DV = 64; static constexpr bool SUBLN = false;
    int row0; const float* z; const float* cache_k; const float* cache_v; const float* rpb; float scale, lam; const float* subln_w; float post_scale;
    __device__ int nkeys(int r) const { return r < NP ? 256 : 128 + 256; }
    __device__ const float* qa(int r, int h, int) const { return z + (size_t)r * NO + O_QN + h * 64; }
    __device__ const float* qb(int, int) const { return nullptr; }
    __device__ int ocol(int h) const { return 512 + h * 64; }
    __device__ void key(int r, int h, int t, KeyRef& k) const {
        k.ok = true; k.bias = 0.f; k.kb = nullptr;
        if (r < NP) { const int rt = (r & ~255) + t; k.ka[0] = z + (size_t)rt * NO + O_KN + h * 64; k.v = z + (size_t)rt * NO + O_VN + h * 64; }
        else { const int b = (r - NP) >> 10, tq = (r - NP) & 1023, qr = tq >> 6, qc = tq & 63;
            if (t < 128) {
                const int i = t >> 4, jc = t & 15;
                int rs = qr - 4; rs = rs < 0 ? 0 : (rs > 8 ? 8 : rs);
                int cs = qc - 8; cs = cs < 0 ? 0 : (cs > 48 ? 48 : cs);
                const int kr = rs + i, kc = cs + jc;
                const int dr = kr - qr + 7; int dc = kc - qc + 15; dc = dc < 0 ? 0 : (dc > 30 ? 30 : dc);
                k.bias = rpb[(h * 15 + dr) * 31 + dc];
                const int rt = NP + b * 1024 + kr * 64 + kc;
                k.ka[0] = z + (size_t)rt * NO + O_KN + h * 64; k.v = z + (size_t)rt * NO + O_VN + h * 64;
            } else { const int ct = b * 256 + (t - 128); k.ka[0] = cache_k + (size_t)ct * 512 + h * 64; k.v = cache_v + (size_t)ct * 512 + h * 64; } }
        k.ka[1] = k.ka[0];
    }
};

__global__ void __launch_bounds__(256) k_convact(const float* __restrict__ z, const float* __restrict__ cw, const float* __restrict__ cb, float* __restrict__ g, int seqlen) {
    const int r = blockIdx.x, s = r % seqlen;
    const float* zr = z + (size_t)r * 5632;
    for (int f = threadIdx.x; f < DFF; f += 256) {
        float gv = cb[f], vv = cb[DFF + f];
        gv += zr[f] * cw[5632 + f]; vv += zr[DFF + f] * cw[5632 + DFF + f];
        if (s > 0) { gv += zr[f - 5632] * cw[f]; vv += zr[DFF + f - 5632] * cw[DFF + f]; }
        if (s < seqlen - 1) { gv += zr[f + 5632] * cw[2 * 5632 + f]; vv += zr[DFF + f + 5632] * cw[2 * 5632 + DFF + f]; }
        g[(size_t)r * DFF + f] = silu_f(gv) * vv;
    }
}
__global__ void k_copy(const float* __restrict__ a, float* __restrict__ b, size_t n4) { const size_t i = (size_t)blockIdx.x * 256 + threadIdx.x; if (i < n4) ((float4*)b)[i] = ((const float4*)a)[i]; }
__global__ void k_lam(const float* __restrict__ dl, float lam_init, float* __restrict__ lam) {
    const int lane = threadIdx.x; float a = dl[lane] * dl[64 + lane], b = dl[128 + lane] * dl[192 + lane];
#pragma unroll
    for (int o = 32; o > 0; o >>= 1) { a += __shfl_xor(a, o); b += __shfl_xor(b, o); }
    if (lane == 0) lam[0] = expf(a) - expf(b) + lam_init;
}

static void gemm(hipStream_t st, const float* A, int lda, const float* B, int ldb, float* C, int ldc, int M, int N, int K) {
    dim3 grid((N + 63) / 64, M / 64);
    hipLaunchKernelGGL(k_gemm, grid, dim3(256), 0, st, A, lda, B, ldb, C, ldc, M, N, K);
}

extern "C" void kernel_launch(void* const* d_in, const int* in_sizes, int n_in, void* d_out, int out_size, void* d_ws, size_t ws_size, hipStream_t stream) {
    const float* x_prompt = (const float*)d_in[0]; const float* x_sample = (const float*)d_in[1]; const float* c = (const float*)d_in[2];
    const float* cache_mla_ckv = (const float*)d_in[3]; const float* cache_mla_kpe = (const float*)d_in[4]; const float* cache_diff_k = (const float*)d_in[5]; const float* cache_diff_v = (const float*)d_in[6];
    const float* cache_gqa_k = (const float*)d_in[7]; const float* cache_gqa_v = (const float*)d_in[8]; const float* cache_na_k = (const float*)d_in[9]; const float* cache_na_v = (const float*)d_in[10];
    const float* c_ctx = (const float*)d_in[11]; const float* norm_w = (const float*)d_in[12]; const float* w_mod = (const float*)d_in[13]; const float* b_mod = (const float*)d_in[14];
    const float* w_in_even = (const float*)d_in[15]; const float* w_out_even = (const float*)d_in[16]; const float* w_uq = (const float*)d_in[17]; const float* q_norm_w = (const float*)d_in[18];
    const float* kv_norm_w = (const float*)d_in[19]; const float* w_uk = (const float*)d_in[20]; const float* w_uv = (const float*)d_in[21]; const float* diff_lam = (const float*)d_in[22];
    const float* diff_subln_w = (const float*)d_in[23]; const float* w_in_odd = (const float*)d_in[24]; const float* w_out_odd = (const float*)d_in[25]; const float* qk_norm_w = (const float*)d_in[26];
    const float* na_rpb = (const float*)d_in[27]; const float* w_up = (const float*)d_in[28]; const float* conv_w = (const float*)d_in[29]; const float* conv_b = (const float*)d_in[30]; const float* w_down = (const float*)d_in[31];
    float* out = (float*)d_out;
    float* ws = (float*)d_ws;
    size_t off = 0;
    float* mod = ws + off; off += 65536;
    float* lam = ws + off; off += 64;
    float* U = ws + off; off += (size_t)NR * D;
    float* Z = ws + off; off += (size_t)NR * NO;
    float* Q = ws + off; off += (size_t)NR * 768;
    float* CQN = ws + off; off += (size_t)NR * 256;
    float* KN = ws + off; off += (size_t)(NR + 1024) * 512;
    float* KV = ws + off; off += (size_t)(NR + 1024) * 512;
    float* CKVALL = ws + off; off += (size_t)(NR + 1024) * 128;
    if (off * 4 > ws_size || n_in != 32 || (size_t)out_size != OUT_END) { fprintf(stderr, "kernel_launch: bad sizes ws %zu need %zu out %d\n", ws_size, off * 4, out_size); return; }
    float* Y = Q;
    float* H = out;

    hipLaunchKernelGGL(k_mod, dim3(24, 2), dim3(256), 0, stream, c, c_ctx, w_mod, b_mod, mod);
    hipLaunchKernelGGL(k_copy, dim3(NP * D / 4 / 256), dim3(256), 0, stream, x_prompt, H, (size_t)NP * D / 4);
    hipLaunchKernelGGL(k_copy, dim3(NS * D / 4 / 256), dim3(256), 0, stream, x_sample, H + (size_t)NP * D, (size_t)NS * D / 4);
    for (int l = 0; l < 2; ++l) {
        const float* modl = mod + (size_t)l * 5 * 6144;
        const float* nw = norm_w + (size_t)l * 4 * D;
        hipLaunchKernelGGL(k_normmod, dim3(NR), dim3(256), 0, stream, H, nw, modl, 0, 1, U);
        if (l == 0) {
            const float lam_init = 0.2f;
            hipLaunchKernelGGL(k_lam, dim3(1), dim3(64), 0, stream, diff_lam, lam_init, lam);
            gemm(stream, U, D, w_in_even, NE, Z, NE, NR, NE, D);
            hipLaunchKernelGGL(k_even_post, dim3(NR), dim3(256), 0, stream, Z, q_norm_w, kv_norm_w, CQN, CKVALL, out);
            hipLaunchKernelGGL(k_copy_cache_ckv, dim3(512), dim3(256), 0, stream, cache_mla_ckv, CKVALL);
            gemm(stream, CQN, 256, w_uq, 768, Q, 768, NR, 768, 256);
            hipLaunchKernelGGL(k_rope_q, dim3(NS), dim3(128), 0, stream, Q);
            gemm(stream, CKVALL, 128, w_uk, 512, KN, 512, NR + 1024, 512, 128);
            gemm(stream, CKVALL, 128, w_uv, 512, KV, 512, NR + 1024, 512, 128);
            PolMLA pm; memset(&pm, 0, sizeof pm); pm.row0 = 0; pm.q = Q; pm.kn = KN; pm.kv = KV; pm.z = Z; pm.cache_kpe = cache_mla_kpe; pm.scale = 0.10206207261596575f; pm.lam = 0.f; pm.subln_w = nullptr; pm.post_scale = 1.f;
            hipLaunchKernelGGL((k_attn<PolMLA, false>), dim3(NR, 8), dim3(128), 0, stream, pm, (const float*)lam, U);
            PolDiff pd; memset(&pd, 0, sizeof pd); pd.row0 = 0; pd.z = Z; pd.cache_k = cache_diff_k; pd.cache_v = cache_diff_v; pd.scale = 0.125f; pd.lam = 0.f; pd.subln_w = diff_subln_w; pd.post_scale = 1.f - lam_init;
            hipLaunchKernelGGL((k_attn<PolDiff, true>), dim3(NR, 4), dim3(128), 0, stream, pd, (const float*)lam, U);
            gemm(stream, U, D, w_out_even, D, Y, D, NR, D, D);
        } else {
            gemm(stream, U, D, w_in_odd, NO, Z, NO, NR, NO, D);
            hipLaunchKernelGGL(k_odd_post, dim3(NR), dim3(64), 0, stream, Z, qk_norm_w, out);
            PolGQA pg; memset(&pg, 0, sizeof pg); pg.row0 = 0; pg.z = Z; pg.cache_k = cache_gqa_k; pg.cache_v = cache_gqa_v; pg.scale = 0.125f; pg.lam = 0.f; pg.subln_w = nullptr; pg.post_scale = 1.f;
            hipLaunchKernelGGL((k_attn<PolGQA, false>), dim3(NR, 8), dim3(128), 0, stream, pg, (const float*)lam, U);
            PolNA pn; memset(&pn, 0, sizeof pn); pn.row0 = 0; pn.z = Z; pn.cache_k = cache_na_k; pn.cache_v = cache_na_v; pn.rpb = na_rpb; pn.scale = 0.125f; pn.lam = 0.f; pn.subln_w = nullptr; pn.post_scale = 1.f;
            hipLaunchKernelGGL((k_attn<PolNA, false>), dim3(NR, 8), dim3(128), 0, stream, pn, (const float*)lam, U);
            gemm(stream, U, D, w_out_odd, D, Y, D, NR, D, D);
        }
        hipLaunchKernelGGL(k_resnorm, dim3(NR), dim3(256), 0, stream, H, Y, nw + D, modl, 2, H);
        hipLaunchKernelGGL(k_normmod, dim3(NR), dim3(256), 0, stream, H, nw + 2 * D, modl, 3, 4, U);
        float* ZC = Z; float* G = Z + (size_t)2048 * 5632;
        for (int ch = 0; ch < NR / 2048; ++ch) {
            const int r0 = ch * 2048; const int seqlen = r0 < NP ? 256 : 1024;
            gemm(stream, U + (size_t)r0 * D, D, w_up + (size_t)l * D * 5632, 5632, ZC, 5632, 2048, 5632, D);
            hipLaunchKernelGGL(k_convact, dim3(2048), dim3(256), 0, stream, ZC, conv_w + (size_t)l * 3 * 5632, conv_b + (size_t)l * 5632, G, seqlen);
            gemm(stream, G, DFF, w_down + (size_t)l * DFF * D, D, Y + (size_t)r0 * D, D, 2048, D, DFF);
        }
        hipLaunchKernelGGL(k_resnorm, dim3(NR), dim3(256), 0, stream, H, Y, nw + 3 * D, modl, 5, H);
    }
}
```

```cpp
#include <hip/hip_runtime.h>
#include <cstdio>
#include <cstdint>
#include <cstring>

constexpr int D = 1024, NP = 8192, NS = 4096, NR = NP + NS;
constexpr int PAST = 256, DFF = 2816;
constexpr int NE = 1952, NO = 2304;
constexpr float EPS = 1e-6f;
constexpr int E_CQ = 0, E_CKV = 256, E_KPE = 384, E_QD = 416, E_KD = 928, E_VD = 1440;
constexpr int O_QC = 0, O_KC = 512, O_VC = 640, O_QN = 768, O_KN = 1280, O_VN = 1792;
constexpr size_t OUT_YP = 0, OUT_YS = (size_t)NP * D, OUT_CKV = (size_t)NR * D, OUT_KPE = OUT_CKV + (size_t)NP * 128, OUT_DK = OUT_KPE + (size_t)NP * 32,
                 OUT_DV = OUT_DK + (size_t)NP * 512, OUT_GK = OUT_DV + (size_t)NP * 512, OUT_GV = OUT_GK + (size_t)NP * 128, OUT_NK = OUT_GV + (size_t)NP * 128,
                 OUT_NV = OUT_NK + (size_t)NP * 512, OUT_END = OUT_NV + (size_t)NP * 512;

__device__ __forceinline__ int row_mod(int r) { return r < NP ? 0 : 1 + ((r - NP) >> 10); }
__device__ __forceinline__ float silu_f(float x) { return x / (1.f + expf(-x)); }

constexpr int MAXK = 1280;
#define LAS __attribute__((address_space(3)))
typedef unsigned short bf16_t;
typedef short bf16x8 __attribute__((ext_vector_type(8)));
typedef float f32x4 __attribute__((ext_vector_type(4)));
typedef float f32x16 __attribute__((ext_vector_type(16)));
typedef unsigned u32x4 __attribute__((ext_vector_type(4)));
typedef unsigned u32x2 __attribute__((ext_vector_type(2)));
__device__ __forceinline__ unsigned cvt_pk_bf16(float lo, float hi) { unsigned r; asm volatile("v_cvt_pk_bf16_f32 %0, %1, %2" : "=v"(r) : "v"(lo), "v"(hi)); return r; }
__device__ __forceinline__ unsigned short f2bf(float f) { return (unsigned short)(cvt_pk_bf16(f, 0.f) & 0xffffu); }
__device__ __forceinline__ float bf2f(unsigned short b) { return __uint_as_float((unsigned)b << 16); }
__device__ __forceinline__ u32x2 pack4(f32x4 v) { u32x2 w; w.x = cvt_pk_bf16(v[0], v[1]); w.y = cvt_pk_bf16(v[2], v[3]); return w; }
constexpr int NKR = NR + 1024;
__device__ __forceinline__ int krow_of(int r) { return r < NP ? r : r + (((r - NP) >> 10) << 8); }
constexpr float LOG2E = 1.4426950408889634f;

constexpr size_t al256(size_t x) { return (x + 255) & ~(size_t)255; }
constexpr size_t WS_CTL = 0;
constexpr size_t WS_MOD = 1u << 20;
constexpr size_t WS_LAM = WS_MOD + al256(2 * 5 * 6144 * 4);
constexpr size_t WS_PSQ = WS_LAM + 256;
constexpr size_t WS_PSKV = WS_PSQ + al256((size_t)NR * 4 * 4);
constexpr size_t WS_WIE = al256(WS_PSKV + (size_t)NKR * 4 * 4);
constexpr size_t WS_WIO = WS_WIE + (size_t)2048 * 1024 * 2;
constexpr size_t WS_WOE = WS_WIO + (size_t)2304 * 1024 * 2;
constexpr size_t WS_WOO = WS_WOE + (size_t)1024 * 1024 * 2;
constexpr size_t WS_WUQ = WS_WOO + (size_t)1024 * 1024 * 2;
constexpr size_t WS_WKV = WS_WUQ + (size_t)768 * 256 * 2;
constexpr size_t WS_WUP = WS_WKV + (size_t)1024 * 256 * 2;
constexpr size_t WS_WDN = WS_WUP + (size_t)2 * 5632 * 1024 * 2;
constexpr size_t WS_XN = WS_WDN + (size_t)2 * 1024 * 2816 * 2;
constexpr size_t WS_O = WS_XN + (size_t)NR * 1024 * 2;
constexpr size_t WS_R = WS_O + (size_t)NR * 1024 * 2;
constexpr size_t WS_Y = WS_R;
constexpr size_t WS_G = WS_Y + (size_t)NR * 1024 * 4;
constexpr size_t WS_R_END_FFN = WS_G + (size_t)NR * 2816 * 2;
constexpr size_t WS_QA = WS_R;
constexpr size_t WS_QD = WS_QA + (size_t)NR * 768 * 2;
constexpr size_t WS_KA = WS_QD + (size_t)NR * 512 * 2;
constexpr size_t WS_KD = WS_KA + (size_t)NKR * 768 * 2;
constexpr size_t WS_VTA = WS_KD + (size_t)NKR * 512 * 2;
constexpr size_t WS_VTD = WS_VTA + (size_t)NKR * 512 * 2;
constexpr size_t WS_CQ = WS_VTD + (size_t)NKR * 512 * 2;
constexpr size_t WS_CKV = WS_CQ + (size_t)NR * 256 * 2;
constexpr size_t WS_R_END_EVEN = WS_CKV + (size_t)NKR * 256 * 2;
constexpr size_t WS_QC = WS_R;
constexpr size_t WS_QN = WS_QC + (size_t)NR * 512 * 2;
constexpr size_t WS_KC = WS_QN + (size_t)NR * 512 * 2;
constexpr size_t WS_KN = WS_KC + (size_t)NKR * 128 * 2;
constexpr size_t WS_VTC = WS_KN + (size_t)NKR * 512 * 2;
constexpr size_t WS_VTN = WS_VTC + (size_t)NKR * 128 * 2;
constexpr size_t WS_R_END_ODD = WS_VTN + (size_t)NKR * 512 * 2;
constexpr size_t WS_FAST_END = WS_R_END_FFN > WS_R_END_EVEN ? (WS_R_END_FFN > WS_R_END_ODD ? WS_R_END_FFN : WS_R_END_ODD) : (WS_R_END_EVEN > WS_R_END_ODD ? WS_R_END_EVEN : WS_R_END_ODD);
static_assert(WS_FAST_END <= 268435456, "fast path fits 256 MiB of workspace");

constexpr int RING_BYTES = 131072;
constexpr int EX_OFF = RING_BYTES;
constexpr int MISC_OFF = EX_OFF + 8192;
constexpr int FAST_LDS_BYTES = 147456;

__device__ __forceinline__ void transpose_item(const float* __restrict__ Wsrc  , int ldw, bf16_t* __restrict__ dst  , int lddst, LAS float* scr, int lane) {
    if (Wsrc) {
#pragma unroll 8
        for (int i = 0; i < 32; ++i) { const int kk = 2 * i + (lane >> 5); scr[kk * 33 + (lane & 31)] = Wsrc[(size_t)kk * ldw + (lane & 31)]; }
    } else {
#pragma unroll 8
        for (int i = 0; i < 32; ++i) { const int kk = 2 * i + (lane >> 5); scr[kk * 33 + (lane & 31)] = 0.f; }
    }
    asm volatile("s_waitcnt lgkmcnt(0)" ::: "memory");
    const int c = lane & 7;
#pragma unroll
    for (int j = 0; j < 4; ++j) { const int n = (lane >> 3) + 8 * j; const LAS float* s = scr + (8 * c) * 33 + n;
        u32x4 o; o.x = cvt_pk_bf16(s[0 * 33], s[1 * 33]); o.y = cvt_pk_bf16(s[2 * 33], s[3 * 33]); o.z = cvt_pk_bf16(s[4 * 33], s[5 * 33]); o.w = cvt_pk_bf16(s[6 * 33], s[7 * 33]);
        *(u32x4*)(dst + (size_t)n * lddst + 8 * c) = o; }
    asm volatile("s_waitcnt lgkmcnt(0)" ::: "memory");
}
enum { WM_NAT = 0, WM_INE = 1, WM_INO = 2, WM_UP = 3 };
__device__ __forceinline__ int wmap(int kind, int nb) {
    if (kind == WM_NAT) return 32 * nb;
    if (kind == WM_UP) { const int pn = nb >> 3, g = nb & 7; return g < 4 ? 128 * pn + 32 * g : DFF + 128 * pn + 32 * (g - 4); }
    const int pn = nb >> 3, g = nb & 7, bj = g >> 2, wc = g & 3;
    if (kind == WM_INE) {
        if (pn == 0) return E_CQ + 32 * g;
        if (pn == 1) return g < 4 ? E_CKV + 32 * g : (g == 4 ? E_KPE : -1);
        if (pn < 4) return E_QD + 64 * (4 * (pn - 2) + wc) + 32 * bj;
        if (pn < 6) return E_KD + 64 * (4 * (pn - 4) + wc) + 32 * bj;
        return E_VD + 32 * (nb - 48);
    }
    if (pn < 2) return O_QC + 64 * (4 * pn + wc) + 32 * bj;
    if (pn == 2) return wc < 2 ? O_KC + 64 * wc + 32 * bj : O_VC + 64 * (wc - 2) + 32 * bj;
    if (pn < 5) return O_QN + 32 * (nb - 24);
    if (pn < 7) return O_KN + 32 * (nb - 40);
    return O_VN + 32 * (nb - 56);
}
__device__ __forceinline__ void conv_matrix(const float* __restrict__ W, int ldw, int Ksrc, int Kpad, bf16_t* __restrict__ Bt, int ngroups, int kind, LAS float* scr, int lane, int gw, int NGW) {
    const int nitems = (Kpad / 64) * ngroups;
    for (int it = gw; it < nitems; it += NGW) {
        const int kb = it / ngroups, nb = it % ngroups; const int src = wmap(kind, nb);
        const float* ws = (src >= 0 && kb * 64 < Ksrc) ? W + (size_t)(kb * 64) * ldw + src : nullptr;
        transpose_item(ws, ldw, Bt + (size_t)(32 * nb) * Kpad + kb * 64, Kpad, scr, lane);
    }
}

namespace pg8 {
#define PG8_LAS __attribute__((address_space(3)))
typedef unsigned short bf16_t;
typedef short bf16x8 __attribute__((ext_vector_type(8)));
typedef float f32x4 __attribute__((ext_vector_type(4)));
typedef unsigned u32x4 __attribute__((ext_vector_type(4)));
constexpr int BM = 256, BK = 64, HALF = 128, HTB = HALF * BK * 2  , STAGE_BYTES = 8 * HTB, NXCD = 8, WGM = 8;

__host__ __device__ __forceinline__ int lds_byte(int r, int c) { const int st = (r >> 4) * 2 + (c >> 5), rr = r & 15, cc = c & 31, ob = rr * 64 + cc * 2; return st * 1024 + (ob ^ (((ob >> 9) & 1) << 5)); }
__host__ __device__ __forceinline__ void stage_rc(int b, int& R, int& C) { const int st = b / 1024, sb = b % 1024, swz = sb ^ (((sb >> 9) & 1) << 5); R = (st >> 1) * 16 + swz / 64; C = (st & 1) * 32 + (swz % 64) / 2; }
__host__ __device__ __forceinline__ int perm32(int rho) { const int n = rho >> 4, i = rho & 15; return 8 * (i >> 2) + 4 * n + (i & 3); }

struct Unit { int pm, pn, arow, wlo, whi; };
struct Gemm { const bf16_t* A; const bf16_t* Bt; int M, N, K; };

struct StaticOrder {
    int nM, nN, nwg, G, c;
    __host__ __device__ void init(int M, int N, int G_, int c_) { nM = M / BM; nN = N / BM; nwg = nM * nN; G = G_; c = c_; }
    __host__ __device__ bool next(int i, Unit& u) const {
        const long L = (long)i * G + c; if (L >= nwg) return false;
        int wgid = (int)L; { const int q = nwg / NXCD, r = nwg % NXCD, xcd = wgid % NXCD, off = wgid / NXCD; wgid = (xcd < r ? xcd * (q + 1) : r * (q + 1) + (xcd - r) * q) + off; }
        const int nig = WGM * nN, gid = wgid / nig, fm = gid * WGM, gsz = (nM - fm) < WGM ? (nM - fm) : WGM;
        u.pm = fm + ((wgid % nig) % gsz); u.pn = (wgid % nig) / gsz; u.arow = u.pm * BM; u.wlo = 0; u.whi = BM; return true;
    }
    __device__ __forceinline__ void a_ready(const Unit&) const {}
    __device__ __forceinline__ void done(const Unit&) const {}
};

template <class Epi, class Sched, bool ALIGN_EPI = false, bool SP2 = false>
__device__ __forceinline__ void gemm_phase(PG8_LAS unsigned char* lds, const Gemm g, const Sched& S, const Epi& E) {
    const int tid = threadIdx.x, wid = __builtin_amdgcn_readfirstlane(tid >> 6), lane = tid & 63, wr = wid >> 2, wc = wid & 3, fr = lane & 15, fq = lane >> 4;
    const int K = g.K, nt = K / BK;
    unsigned voffA[2], voffB[2];
#pragma unroll
    for (int i = 0; i < 2; ++i) { int R, C; stage_rc(tid * 16 + i * 8192, R, C); const int Rb = Epi::PERM ? ((R & ~31) + perm32(R & 31)) : R;
        voffA[i] = (unsigned)(R * K + C) * 2u; voffB[i] = (unsigned)(Rb * K + C) * 2u; }
    const size_t kstep = (size_t)(BK * 2);
    const size_t hstep = (size_t)HALF * K * 2;
    const size_t tstep = 2 * hstep;
    const unsigned ldsw = (unsigned)wid * 1024u;
    const int aoff = lds_byte(wr * 64 + fr, fq * 8), boff = lds_byte(wc * 32 + fr, fq * 8);
#define PG8_SA(b, h) (((b) * 2 + (h)) * HTB)
#define PG8_SB(b, h) ((4 + (b) * 2 + (h)) * HTB)
#define PG8_STAGE(bufoff, gbase, voff) do { _Pragma("unroll") for (int _i = 0; _i < 2; ++_i) \
        __builtin_amdgcn_global_load_lds((const unsigned*)((const char*)(gbase) + (voff)[_i]), (PG8_LAS unsigned*)(lds + (bufoff) + ldsw + _i * 8192), 16, 0, 0); } while (0)
#define PG8_LDA(dst, b, h) do { _Pragma("unroll") for (int m = 0; m < 4; ++m) _Pragma("unroll") for (int k = 0; k < 2; ++k) dst[m][k] = *(const PG8_LAS bf16x8*)(lds + PG8_SA(b, h) + aoff + m * 2048 + k * 1024); } while (0)
#define PG8_LDB(dst, b, h) do { _Pragma("unroll") for (int n = 0; n < 2; ++n) _Pragma("unroll") for (int k = 0; k < 2; ++k) dst[n][k] = *(const PG8_LAS bf16x8*)(lds + PG8_SB(b, h) + boff + n * 2048 + k * 1024); } while (0)
#define PG8_MMA(ai, bj, At, Bt) do { __builtin_amdgcn_s_setprio(1); _Pragma("unroll") for (int m = 0; m < 4; ++m) _Pragma("unroll") for (int n = 0; n < 2; ++n) _Pragma("unroll") for (int k = 0; k < 2; ++k) \
        acc[ai][bj][m][n] = __builtin_amdgcn_mfma_f32_16x16x32_bf16(Bt[n][k], At[m][k], acc[ai][bj][m][n], 0, 0, 0); __builtin_amdgcn_s_setprio(0); } while (0)
#define PG8_WAIT_V(n) asm volatile("s_waitcnt vmcnt(" #n ")" ::: "memory")
#define PG8_WAIT_L(n) asm volatile("s_waitcnt lgkmcnt(" #n ")" ::: "memory")
#define PG8_BAR __builtin_amdgcn_s_barrier()
#define PG8_SCHED __builtin_amdgcn_sched_barrier(0)
    Unit cur, nxt; int ui = 0;
    if (!S.next(0, cur)) return;
    f32x4 acc[2][2][4][2];
#pragma unroll
    for (int a = 0; a < 2; ++a)
#pragma unroll
        for (int b = 0; b < 2; ++b)
#pragma unroll
            for (int m = 0; m < 4; ++m)
#pragma unroll
                for (int n = 0; n < 2; ++n) acc[a][b][m][n] = (f32x4){0.f, 0.f, 0.f, 0.f};
    bf16x8 At[4][2], B0[2][2], B1[2][2];
    const char* cA = (const char*)g.A + (size_t)cur.arow * (size_t)(K * 2); const char* cB = (const char*)g.Bt + (size_t)cur.pn * tstep;
    S.a_ready(cur);
    if constexpr (SP2) {
        PG8_STAGE(PG8_SB(0, 0), cB, voffB); PG8_STAGE(PG8_SB(0, 1), cB + hstep, voffB); PG8_STAGE(PG8_SA(0, 0), cA, voffA); PG8_STAGE(PG8_SA(0, 1), cA + hstep, voffA);
        if (wr == 1) PG8_BAR;
        PG8_WAIT_V(2); PG8_BAR;
        PG8_STAGE(PG8_SB(1, 0), cB + kstep, voffB); PG8_STAGE(PG8_SA(1, 0), cA + kstep, voffA); PG8_STAGE(PG8_SB(1, 1), cB + hstep + kstep, voffB);
        PG8_WAIT_V(6); PG8_BAR;
    } else {
        PG8_STAGE(PG8_SB(0, 0), cB, voffB); PG8_STAGE(PG8_SA(0, 0), cA, voffA); PG8_STAGE(PG8_SB(0, 1), cB + hstep, voffB); PG8_STAGE(PG8_SA(0, 1), cA + hstep, voffA);
        if (wr == 1) PG8_BAR;
        PG8_WAIT_V(4); PG8_BAR;
        PG8_STAGE(PG8_SB(1, 0), cB + kstep, voffB); PG8_STAGE(PG8_SA(1, 0), cA + kstep, voffA); PG8_STAGE(PG8_SB(1, 1), cB + hstep + kstep, voffB);
        PG8_WAIT_V(6); PG8_BAR;
    }
    for (;;) {
        const bool has_next = S.next(ui + 1, nxt);
        const char* nA = has_next ? (const char*)g.A + (size_t)nxt.arow * (size_t)(K * 2) : cA; const char* nB = has_next ? (const char*)g.Bt + (size_t)nxt.pn * tstep : cB;
        for (int t = 0; t < nt; t += 2) {
            const bool last = (t == nt - 2);
            const char* a1 = cA + (size_t)(t + 1) * kstep;
            const char* a2 = last ? nA : cA + (size_t)(t + 2) * kstep; const char* b2 = last ? nB : cB + (size_t)(t + 2) * kstep;
            const char* a3 = a2 + kstep; const char* b3 = b2 + kstep;
            if (last && has_next) S.a_ready(nxt);
            if constexpr (SP2) {
            PG8_LDB(B0, 0, 0); PG8_LDB(B1, 0, 1); PG8_SCHED; PG8_LDA(At, 0, 0); PG8_STAGE(PG8_SA(1, 1), a1 + hstep, voffA);
            PG8_WAIT_V(8); PG8_WAIT_L(0); PG8_BAR; PG8_MMA(0, 0, At, B0); PG8_MMA(0, 1, At, B1); PG8_BAR; PG8_SCHED;
            PG8_LDA(At, 0, 1); PG8_STAGE(PG8_SB(0, 0), b2, voffB); PG8_STAGE(PG8_SB(0, 1), b2 + hstep, voffB); PG8_STAGE(PG8_SA(0, 0), a2, voffA);
            PG8_WAIT_V(8); PG8_WAIT_L(0); PG8_BAR; PG8_MMA(1, 0, At, B0); PG8_MMA(1, 1, At, B1); PG8_BAR; PG8_SCHED;
            PG8_LDB(B0, 1, 0); PG8_LDB(B1, 1, 1); PG8_SCHED; PG8_LDA(At, 1, 0); PG8_STAGE(PG8_SA(0, 1), a2 + hstep, voffA);
            PG8_WAIT_V(8); PG8_WAIT_L(0); PG8_BAR; PG8_MMA(0, 0, At, B0); PG8_MMA(0, 1, At, B1); PG8_BAR; PG8_SCHED;
            PG8_LDA(At, 1, 1); PG8_STAGE(PG8_SB(1, 0), b3, voffB); PG8_STAGE(PG8_SB(1, 1), b3 + hstep, voffB); PG8_STAGE(PG8_SA(1, 0), a3, voffA);
            PG8_WAIT_V(8); PG8_WAIT_L(0); PG8_BAR; PG8_MMA(1, 0, At, B0); PG8_MMA(1, 1, At, B1); PG8_BAR; PG8_SCHED;
            } else {
            PG8_LDB(B0, 0, 0); PG8_SCHED; PG8_LDA(At, 0, 0); PG8_STAGE(PG8_SA(1, 1), a1 + hstep, voffA);
            PG8_WAIT_L(8); PG8_BAR; PG8_WAIT_L(0); PG8_MMA(0, 0, At, B0); PG8_BAR; PG8_SCHED;
            PG8_LDB(B1, 0, 1); PG8_STAGE(PG8_SB(0, 0), b2, voffB);
            PG8_BAR; PG8_WAIT_L(0); PG8_MMA(0, 1, At, B1); PG8_BAR;
            PG8_LDA(At, 0, 1); PG8_STAGE(PG8_SA(0, 0), a2, voffA);
            PG8_BAR; PG8_WAIT_L(0); PG8_MMA(1, 0, At, B0); PG8_BAR; PG8_SCHED;
            PG8_STAGE(PG8_SB(0, 1), b2 + hstep, voffB);
            PG8_WAIT_V(6); PG8_BAR; PG8_MMA(1, 1, At, B1); PG8_BAR;
            PG8_LDB(B0, 1, 0); PG8_SCHED; PG8_LDA(At, 1, 0); PG8_STAGE(PG8_SA(0, 1), a2 + hstep, voffA);
            PG8_WAIT_L(8); PG8_BAR; PG8_WAIT_L(0); PG8_MMA(0, 0, At, B0); PG8_BAR; PG8_SCHED;
            PG8_LDB(B1, 1, 1); PG8_STAGE(PG8_SB(1, 0), b3, voffB);
            PG8_BAR; PG8_WAIT_L(0); PG8_MMA(0, 1, At, B1); PG8_BAR;
            PG8_LDA(At, 1, 1); PG8_STAGE(PG8_SA(1, 0), a3, voffA);
            PG8_BAR; PG8_WAIT_L(0); PG8_MMA(1, 0, At, B0); PG8_BAR; PG8_SCHED;
            PG8_STAGE(PG8_SB(1, 1), b3 + hstep, voffB);
            PG8_WAIT_V(6); PG8_BAR; PG8_MMA(1, 1, At, B1); PG8_BAR;
            }
        }
        if constexpr (ALIGN_EPI) { if (wr == 0) PG8_BAR; }
        if constexpr (!Epi::AFTER_DRAIN) { E(acc, cur, wr, wc, fr, fq); S.done(cur); }
        if (!has_next) break;
#pragma unroll
        for (int a = 0; a < 2; ++a)
#pragma unroll
            for (int b = 0; b < 2; ++b)
#pragma unroll
                for (int m = 0; m < 4; ++m)
#pragma unroll
                    for (int n = 0; n < 2; ++n) acc[a][b][m][n] = (f32x4){0.f, 0.f, 0.f, 0.f};
        cur = nxt; cA = nA; cB = nB; ++ui;
        if constexpr (ALIGN_EPI) { if (wr == 1) PG8_BAR; }
    }
    PG8_WAIT_V(0);
    if constexpr (!ALIGN_EPI) { if (wr == 0) PG8_BAR; }
    PG8_BAR;
    if constexpr (Epi::AFTER_DRAIN) { E.fused(acc, cur, wr, wc, fr, fq, lds, wid, lane); S.done(cur); }
#undef PG8_SA
#undef PG8_SB
#undef PG8_STAGE
#undef PG8_LDA
#undef PG8_LDB
#undef PG8_MMA
#undef PG8_WAIT_V
#undef PG8_WAIT_L
#undef PG8_BAR
#undef PG8_SCHED
}
}

struct EpiF32 {
    static constexpr bool PERM = false, AFTER_DRAIN = false;
    float* C; int ldc;
    __device__ __forceinline__ void operator()(const f32x4 (&acc)[2][2][4][2], const pg8::Unit& u, int wr, int wc, int fr, int fq) const {
#pragma unroll
        for (int ai = 0; ai < 2; ++ai)
#pragma unroll
            for (int m = 0; m < 4; ++m) { float* rowp = C + (size_t)(u.arow + ai * 128 + wr * 64 + m * 16 + fr) * ldc + u.pn * 256 + wc * 32 + 4 * fq;
#pragma unroll
                for (int bj = 0; bj < 2; ++bj)
#pragma unroll
                    for (int n = 0; n < 2; ++n) *(f32x4*)(rowp + bj * 128 + n * 16) = acc[ai][bj][m][n]; }
    }
};
__device__ __forceinline__ f32x4 shfl4(f32x4 v, int src) { f32x4 r; r[0] = __shfl(v[0], src); r[1] = __shfl(v[1], src); r[2] = __shfl(v[2], src); r[3] = __shfl(v[3], src); return r; }
__device__ __forceinline__ f32x4 sel4(bool c, f32x4 a, f32x4 b) { f32x4 r; r[0] = c ? a[0] : b[0]; r[1] = c ? a[1] : b[1]; r[2] = c ? a[2] : b[2]; r[3] = c ? a[3] : b[3]; return r; }
struct EpiUpConv {
    static constexpr bool PERM = false, AFTER_DRAIN = false;
    bf16_t* G; const float* cw; const float* cb; LAS f32x4* ex;
    __device__ __forceinline__ void operator()(const f32x4 (&acc)[2][2][4][2], const pg8::Unit& u, int wr, int wc, int fr, int fq) const {
        const int lane = fq * 16 + fr;
#pragma unroll
        for (int ai = 0; ai < 2; ++ai) { const int s = 2 * ai + wr;
            if (fr == 0) {
#pragma unroll
                for (int bj = 0; bj < 2; ++bj)
#pragma unroll
                    for (int n = 0; n < 2; ++n) ex[(((s * 4 + wc) * 2 + 0) * 4 + bj * 2 + n) * 4 + fq] = acc[ai][bj][0][n]; }
            if (fr == 15) {
#pragma unroll
                for (int bj = 0; bj < 2; ++bj)
#pragma unroll
                    for (int n = 0; n < 2; ++n) ex[(((s * 4 + wc) * 2 + 1) * 4 + bj * 2 + n) * 4 + fq] = acc[ai][bj][3][n]; }
        }
        asm volatile("s_waitcnt lgkmcnt(0)" ::: "memory"); __builtin_amdgcn_s_barrier(); asm volatile("" ::: "memory");
        const int up = (lane & 48) | ((fr + 15) & 15), dn = (lane & 48) | ((fr + 1) & 15);
        const f32x4 zero4 = {0.f, 0.f, 0.f, 0.f};
#pragma unroll
        for (int n = 0; n < 2; ++n) {
            const int col = u.pn * 128 + wc * 32 + n * 16 + 4 * fq;
            const f32x4 g0 = *(const f32x4*)(cw + col), g1 = *(const f32x4*)(cw + 5632 + col), g2 = *(const f32x4*)(cw + 2 * 5632 + col), gb = *(const f32x4*)(cb + col);
            const f32x4 v0 = *(const f32x4*)(cw + DFF + col), v1 = *(const f32x4*)(cw + 5632 + DFF + col), v2 = *(const f32x4*)(cw + 2 * 5632 + DFF + col), vb = *(const f32x4*)(cb + DFF + col);
#pragma unroll
            for (int ai = 0; ai < 2; ++ai) { const int s = 2 * ai + wr;
                f32x4 ag = zero4, av = zero4, bg = zero4, bv = zero4;
                if (fr == 0 && s > 0) { ag = ex[((((s - 1) * 4 + wc) * 2 + 1) * 4 + 0 * 2 + n) * 4 + fq]; av = ex[((((s - 1) * 4 + wc) * 2 + 1) * 4 + 1 * 2 + n) * 4 + fq]; }
                if (fr == 15 && s < 3) { bg = ex[((((s + 1) * 4 + wc) * 2 + 0) * 4 + 0 * 2 + n) * 4 + fq]; bv = ex[((((s + 1) * 4 + wc) * 2 + 0) * 4 + 1 * 2 + n) * 4 + fq]; }
#pragma unroll
                for (int m = 0; m < 4; ++m) {
                    const f32x4 cg = acc[ai][0][m][n], cv = acc[ai][1][m][n];
                    f32x4 pg, pv, ng, nv;
                    if (m == 0) { pg = sel4(fr == 0, ag, shfl4(cg, up)); pv = sel4(fr == 0, av, shfl4(cv, up)); }
                    else { pg = shfl4(sel4(fr == 15, acc[ai][0][m - 1][n], cg), up); pv = shfl4(sel4(fr == 15, acc[ai][1][m - 1][n], cv), up); }
                    if (m == 3) { ng = sel4(fr == 15, bg, shfl4(cg, dn)); nv = sel4(fr == 15, bv, shfl4(cv, dn)); }
                    else { ng = shfl4(sel4(fr == 0, acc[ai][0][m + 1][n], cg), dn); nv = shfl4(sel4(fr == 0, acc[ai][1][m + 1][n], cv), dn); }
                    const f32x4 zg = g0 * pg + g1 * cg + g2 * ng + gb, zv = v0 * pv + v1 * cv + v2 * nv + vb;
                    f32x4 o;
#pragma unroll
                    for (int j = 0; j < 4; ++j) o[j] = zg[j] * __builtin_amdgcn_rcpf(1.f + __builtin_amdgcn_exp2f(-LOG2E * zg[j])) * zv[j];
                    const int rt = ai * 128 + wr * 64 + m * 16 + fr;
                    if (rt >= u.wlo && rt < u.whi) *(u32x2*)(G + (size_t)(u.arow + rt) * DFF + col) = pack4(o);
                }
            }
        }
    }
};
struct UpOrder {
    pg8::StaticOrder so;
    __device__ void init(int G, int c) { so.init(52 * 256, 5632, G, c); }
    __device__ bool next(int i, pg8::Unit& u) const {
        if (!so.next(i, u)) return false;
        if (u.pm < 32) { u.arow = 256 * u.pm; u.wlo = 0; u.whi = 256; }
        else { const int s = (u.pm - 32) / 5, k = (u.pm - 32) % 5; const int st = k < 4 ? 254 * k : 768;
            u.arow = NP + 1024 * s + st; u.wlo = k == 0 ? 0 : (k == 4 ? 249 : 1); u.whi = k == 4 ? 256 : 255; }
        return true;
    }
    __device__ __forceinline__ void a_ready(const pg8::Unit&) const {}
    __device__ __forceinline__ void done(const pg8::Unit&) const {}
};

constexpr size_t WS_ROPE64 = WS_CTL + 65536;
constexpr size_t WS_ROPE32 = WS_ROPE64 + 1024 * 64 * 4;
static_assert(WS_ROPE32 + 1024 * 32 * 4 <= WS_MOD, "rope tables fit below WS_MOD");

struct FastP {
    const float *x_prompt, *x_sample, *c, *cache_mla_ckv, *cache_mla_kpe, *cache_diff_k, *cache_diff_v, *cache_gqa_k, *cache_gqa_v, *cache_na_k, *cache_na_v, *c_ctx, *norm_w, *w_mod, *b_mod,
        *w_in_even, *w_out_even, *w_uq, *q_norm_w, *kv_norm_w, *w_uk, *w_uv, *diff_lam, *diff_subln_w, *w_in_odd, *w_out_odd, *qk_norm_w, *na_rpb, *w_up, *conv_w, *conv_b, *w_down;
    float* out; unsigned char* ws;
};
__device__ __forceinline__ float wave_sum(float v) {
#pragma unroll
    for (int o = 1; o < 64; o <<= 1) v += __shfl_xor(v, o);
    return v;
}
__device__ __forceinline__ void mods_phase(const FastP& p, LAS unsigned char* lds, int tid, int bid, int nblk) {
    LAS float* sc = (LAS float*)lds; LAS float* part = sc + 5 * 1024;
    const int lane = tid & 63, wave = tid >> 6;
    for (int i = tid; i < 5 * 1024; i += 512) { const int j = i >> 10, k = i & 1023; const float v = j == 0 ? p.c_ctx[k] : p.c[(j - 1) * 1024 + k]; sc[i] = v / (1.f + expf(-v)); }
    __syncthreads();
    float* MOD = (float*)(p.ws + WS_MOD);
    for (int it = bid; it < 2 * 96; it += nblk) {
        const int l = it / 96, n = (it % 96) * 64 + lane;
        const float* w = p.w_mod + (size_t)l * 1024 * 6144 + (size_t)(wave * 128) * 6144 + n;
        float a0 = 0.f, a1 = 0.f, a2 = 0.f, a3 = 0.f, a4 = 0.f;
#pragma unroll 8
        for (int k = 0; k < 128; ++k) { const float wv = w[(size_t)k * 6144]; const int kk = wave * 128 + k;
            a0 += sc[kk] * wv; a1 += sc[1024 + kk] * wv; a2 += sc[2048 + kk] * wv; a3 += sc[3072 + kk] * wv; a4 += sc[4096 + kk] * wv; }
        part[(wave * 5 + 0) * 64 + lane] = a0; part[(wave * 5 + 1) * 64 + lane] = a1; part[(wave * 5 + 2) * 64 + lane] = a2; part[(wave * 5 + 3) * 64 + lane] = a3; part[(wave * 5 + 4) * 64 + lane] = a4;
        __syncthreads();
        if (tid < 320) { const int j = tid >> 6; float s = 0.f;
#pragma unroll
            for (int w8 = 0; w8 < 8; ++w8) s += part[(w8 * 5 + j) * 64 + lane];
            MOD[((size_t)l * 5 + j) * 6144 + n] = s + p.b_mod[l * 6144 + n]; }
        __syncthreads();
    }
}
__device__ __forceinline__ void misc_prologue(const FastP& p, int gtid, int gn) {
    float* R64 = (float*)(p.ws + WS_ROPE64); float* R32 = (float*)(p.ws + WS_ROPE32);
    for (int i = gtid; i < 1024 * 32; i += gn) { const int t = i >> 5, a = i & 31; const int fi = a & 15; const int pos = a < 16 ? (t >> 6) : (t & 63);
        const float ang = (float)pos * expf(-9.210340371976184f * (float)fi / 16.f); R64[t * 64 + a] = cosf(ang); R64[t * 64 + 32 + a] = sinf(ang); }
    for (int i = gtid; i < 1024 * 16; i += gn) { const int t = i >> 4, a = i & 15; const int fi = a & 7; const int pos = a < 8 ? (t >> 6) : (t & 63);
        const float ang = (float)pos * expf(-9.210340371976184f * (float)fi / 8.f); R32[t * 32 + a] = cosf(ang); R32[t * 32 + 16 + a] = sinf(ang); }
    if (gtid < 64) { float a = p.diff_lam[gtid] * p.diff_lam[64 + gtid], b = p.diff_lam[128 + gtid] * p.diff_lam[192 + gtid]; a = wave_sum(a); b = wave_sum(b);
        if (gtid == 0) *(float*)(p.ws + WS_LAM) = expf(a) - expf(b) + 0.2f; }
    bf16_t* CKV = (bf16_t*)(p.ws + WS_CKV); bf16_t* KA = (bf16_t*)(p.ws + WS_KA); bf16_t* KD = (bf16_t*)(p.ws + WS_KD); bf16_t* VTD = (bf16_t*)(p.ws + WS_VTD);
    for (int i = gtid; i < NKR * 128; i += gn) { const int kr = i >> 7, c = i & 127; CKV[(size_t)kr * 256 + 128 + c] = 0; }
    for (int i = gtid; i < 1024 * 128; i += gn) { const int ct = i >> 7, c = i & 127, b = ct >> 8, t = ct & 255; const int kr = NP + b * 1280 + 1024 + t;
        CKV[(size_t)kr * 256 + c] = f2bf(p.cache_mla_ckv[i]); }
    for (int i = gtid; i < 1024 * 32 * 8; i += gn) { const int h = i & 7, e = i >> 3, ct = e >> 5, d = e & 31, b = ct >> 8, t = ct & 255; const int kr = NP + b * 1280 + 1024 + t;
        KA[(size_t)kr * 768 + h * 96 + 64 + d] = f2bf(p.cache_mla_kpe[e]); }
    for (int i = gtid; i < 1024 * 512; i += gn) { const int ct = i >> 9, c = i & 511, b = ct >> 8, t = ct & 255; const int kr = NP + b * 1280 + 1024 + t;
        KD[(size_t)kr * 512 + c] = f2bf(p.cache_diff_k[i]); VTD[(size_t)c * NKR + kr] = f2bf(p.cache_diff_v[i]); }
}
__device__ __forceinline__ void ctx_odd(const FastP& p, int gtid, int gn) {
    bf16_t* KC = (bf16_t*)(p.ws + WS_KC); bf16_t* KN = (bf16_t*)(p.ws + WS_KN); bf16_t* VTC = (bf16_t*)(p.ws + WS_VTC); bf16_t* VTN = (bf16_t*)(p.ws + WS_VTN);
    for (int i = gtid; i < 1024 * 128; i += gn) { const int ct = i >> 7, c = i & 127, b = ct >> 8, t = ct & 255; const int kr = NP + b * 1280 + 1024 + t;
        KC[(size_t)kr * 128 + c] = f2bf(p.cache_gqa_k[i]); VTC[(size_t)c * NKR + kr] = f2bf(p.cache_gqa_v[i]); }
    for (int i = gtid; i < 1024 * 512; i += gn) { const int ct = i >> 9, c = i & 511, b = ct >> 8, t = ct & 255; const int kr = NP + b * 1280 + 1024 + t;
        KN[(size_t)kr * 512 + c] = f2bf(p.cache_na_k[i]); VTN[(size_t)c * NKR + kr] = f2bf(p.cache_na_v[i]); }
}
__device__ __forceinline__ void conv_all_weights(const FastP& p, LAS float* scr, int lane, int gw, int NGW) {
    unsigned char* ws = p.ws;
    conv_matrix(p.w_in_even, NE, 1024, 1024, (bf16_t*)(ws + WS_WIE), 64, WM_INE, scr, lane, gw, NGW);
    conv_matrix(p.w_in_odd, NO, 1024, 1024, (bf16_t*)(ws + WS_WIO), 72, WM_INO, scr, lane, gw, NGW);
    conv_matrix(p.w_out_even, 1024, 1024, 1024, (bf16_t*)(ws + WS_WOE), 32, WM_NAT, scr, lane, gw, NGW);
    conv_matrix(p.w_out_odd, 1024, 1024, 1024, (bf16_t*)(ws + WS_WOO), 32, WM_NAT, scr, lane, gw, NGW);
    conv_matrix(p.w_uq, 768, 256, 256, (bf16_t*)(ws + WS_WUQ), 24, WM_NAT, scr, lane, gw, NGW);
    conv_matrix(p.w_uk, 512, 128, 256, (bf16_t*)(ws + WS_WKV), 16, WM_NAT, scr, lane, gw, NGW);
    conv_matrix(p.w_uv, 512, 128, 256, (bf16_t*)(ws + WS_WKV) + (size_t)512 * 256, 16, WM_NAT, scr, lane, gw, NGW);
    for (int l = 0; l < 2; ++l) {
        conv_matrix(p.w_up + (size_t)l * 1024 * 5632, 5632, 1024, 1024, (bf16_t*)(ws + WS_WUP) + (size_t)l * 5632 * 1024, 176, WM_UP, scr, lane, gw, NGW);
        conv_matrix(p.w_down + (size_t)l * 2816 * 1024, 1024, 2816, 2816, (bf16_t*)(ws + WS_WDN) + (size_t)l * 1024 * 2816, 32, WM_NAT, scr, lane, gw, NGW);
    }
}
template <bool HASY, bool HASX, bool CKVFIX = false>
__device__ __forceinline__ void row_phase(const float* hin_p, const float* hin_s, float* hout, const float* __restrict__ y, const float* __restrict__ nwy, const float* __restrict__ mody  , int gate_i,
                                          const float* __restrict__ nwx, const float* __restrict__ modx, int shift_i, int scale_i, bf16_t* __restrict__ xn, int lane, int gw, int NGW, const float* __restrict__ pskv = nullptr) {
    for (int r = gw; r < NR; r += NGW) {
        const int jm = r < NP ? 0 : 1 + ((r - NP) >> 10);
        const float* hr = r < NP ? hin_p + (size_t)r * D : hin_s + (size_t)(r - NP) * D;
        f32x4 h[4];
#pragma unroll
        for (int j = 0; j < 4; ++j) h[j] = *(const f32x4*)(hr + 4 * lane + 256 * j);
        if (CKVFIX && r < NP) {
            const f32x4 ps = *(const f32x4*)(pskv + (size_t)r * 4); const float rs = rsqrtf((ps[0] + ps[1] + ps[2] + ps[3]) * (1.f / 128.f) + EPS);
            float* po = hout + OUT_CKV + (size_t)r * 128 + 2 * lane; po[0] *= rs; po[1] *= rs; }
        if (HASY) {
            f32x4 yv[4]; float ss = 0.f;
#pragma unroll
            for (int j = 0; j < 4; ++j) { yv[j] = *(const f32x4*)(y + (size_t)r * D + 4 * lane + 256 * j); ss += yv[j][0] * yv[j][0] + yv[j][1] * yv[j][1] + yv[j][2] * yv[j][2] + yv[j][3] * yv[j][3]; }
            const float rstd = rsqrtf(wave_sum(ss) * (1.f / D) + EPS);
#pragma unroll
            for (int j = 0; j < 4; ++j) { const f32x4 w = *(const f32x4*)(nwy + 4 * lane + 256 * j), g = *(const f32x4*)(mody + (size_t)jm * 6144 + gate_i * 1024 + 4 * lane + 256 * j);
                h[j] = h[j] + g * yv[j] * rstd * w; }
        }
#pragma unroll
        for (int j = 0; j < 4; ++j) *(f32x4*)(hout + (size_t)r * D + 4 * lane + 256 * j) = h[j];
        if (HASX) {
            float ss = 0.f;
#pragma unroll
            for (int j = 0; j < 4; ++j) ss += h[j][0] * h[j][0] + h[j][1] * h[j][1] + h[j][2] * h[j][2] + h[j][3] * h[j][3];
            const float rstd = rsqrtf(wave_sum(ss) * (1.f / D) + EPS);
#pragma unroll
            for (int j = 0; j < 4; ++j) { const f32x4 w = *(const f32x4*)(nwx + 4 * lane + 256 * j), sc = *(const f32x4*)(modx + (size_t)jm * 6144 + scale_i * 1024 + 4 * lane + 256 * j),
                    sh = *(const f32x4*)(modx + (size_t)jm * 6144 + shift_i * 1024 + 4 * lane + 256 * j);
                const f32x4 o = h[j] * rstd * w * (1.f + sc) + sh; *(u32x2*)(xn + (size_t)r * D + 4 * lane + 256 * j) = pack4(o); }
        }
    }
}

__device__ __forceinline__ void store_vt(bf16_t* VT, int c0, int kr, f32x4 v) {
    const unsigned a = cvt_pk_bf16(v[0], v[1]), b = cvt_pk_bf16(v[2], v[3]);
    VT[(size_t)(c0 + 0) * NKR + kr] = (bf16_t)(a & 0xffffu); VT[(size_t)(c0 + 1) * NKR + kr] = (bf16_t)(a >> 16);
    VT[(size_t)(c0 + 2) * NKR + kr] = (bf16_t)(b & 0xffffu); VT[(size_t)(c0 + 3) * NKR + kr] = (bf16_t)(b >> 16);
}
__device__ __forceinline__ float ss4(f32x4 v) { return v[0] * v[0] + v[1] * v[1] + v[2] * v[2] + v[3] * v[3]; }
__device__ __forceinline__ void rope64(f32x4& x1, f32x4& x2, const float* tab, int n, int fq) {
    const f32x4 cs = *(const f32x4*)(tab + 16 * n + 4 * fq), sn = *(const f32x4*)(tab + 32 + 16 * n + 4 * fq);
    const f32x4 a = x1 * cs - x2 * sn, b = x1 * sn + x2 * cs; x1 = a; x2 = b;
}
constexpr float QSCALE64 = 0.125f * LOG2E, QSCALE96 = 0.10206207261596575f * LOG2E;

struct EpiInE {
    static constexpr bool PERM = false, AFTER_DRAIN = false;
    bf16_t *CQ, *CKV, *KA, *QD, *KD, *VTD; float *PSQ, *PSKV; float* out; const float *qnw, *kvnw, *R64, *R32;
    __device__ __forceinline__ void operator()(const f32x4 (&acc)[2][2][4][2], const pg8::Unit& u, int wr, int wc, int fr, int fq) const {
        const bool sample = u.arow >= NP; const int kbase = krow_of(u.arow);
        if (u.pn == 0) {
#pragma unroll
            for (int ai = 0; ai < 2; ++ai)
#pragma unroll
                for (int m = 0; m < 4; ++m) { const int rt = ai * 128 + wr * 64 + m * 16 + fr, r = u.arow + rt; float ss = 0.f;
#pragma unroll
                    for (int bj = 0; bj < 2; ++bj)
#pragma unroll
                        for (int n = 0; n < 2; ++n) { const int c = bj * 128 + wc * 32 + n * 16 + 4 * fq; const f32x4 v = acc[ai][bj][m][n]; ss += ss4(v);
                            *(u32x2*)(CQ + (size_t)r * 256 + c) = pack4(v * *(const f32x4*)(qnw + c)); }
                    ss += __shfl_xor(ss, 16); ss += __shfl_xor(ss, 32);
                    if (fq == 0) PSQ[(size_t)r * 4 + wc] = ss; }
        } else if (u.pn == 1) {
#pragma unroll
            for (int ai = 0; ai < 2; ++ai)
#pragma unroll
                for (int m = 0; m < 4; ++m) { const int rt = ai * 128 + wr * 64 + m * 16 + fr, r = u.arow + rt, kr = kbase + rt; float ss = 0.f;
#pragma unroll
                    for (int n = 0; n < 2; ++n) { const int c = wc * 32 + n * 16 + 4 * fq; const f32x4 v = acc[ai][0][m][n]; ss += ss4(v); const f32x4 vw = v * *(const f32x4*)(kvnw + c);
                        *(u32x2*)(CKV + (size_t)kr * 256 + c) = pack4(vw);
                        if (!sample) *(f32x4*)(out + OUT_CKV + (size_t)r * 128 + c) = vw; }
                    ss += __shfl_xor(ss, 16); ss += __shfl_xor(ss, 32);
                    if (fq == 0) PSKV[(size_t)kr * 4 + wc] = ss;
                    if (wc == 0) {
                        f32x4 x1 = acc[ai][1][m][0], x2 = acc[ai][1][m][1];
                        if (!sample) { *(f32x4*)(out + OUT_KPE + (size_t)r * 32 + 4 * fq) = x1; *(f32x4*)(out + OUT_KPE + (size_t)r * 32 + 16 + 4 * fq) = x2; }
                        else { const float* tab = R32 + (size_t)((r - NP) & 1023) * 32; const f32x4 cs = *(const f32x4*)(tab + 4 * fq), sn = *(const f32x4*)(tab + 16 + 4 * fq);
                            const f32x4 a = x1 * cs - x2 * sn, b = x1 * sn + x2 * cs; x1 = a; x2 = b; }
                        const u32x2 p1 = pack4(x1), p2 = pack4(x2);
#pragma unroll
                        for (int h = 0; h < 8; ++h) { *(u32x2*)(KA + (size_t)kr * 768 + h * 96 + 64 + 4 * fq) = p1; *(u32x2*)(KA + (size_t)kr * 768 + h * 96 + 80 + 4 * fq) = p2; }
                    } }
        } else if (u.pn < 6) {
            const bool isq = u.pn < 4; const int sh = 4 * ((u.pn - 2) & 1) + wc;
#pragma unroll
            for (int ai = 0; ai < 2; ++ai)
#pragma unroll
                for (int m = 0; m < 4; ++m) { const int rt = ai * 128 + wr * 64 + m * 16 + fr, r = u.arow + rt, kr = kbase + rt;
#pragma unroll
                    for (int n = 0; n < 2; ++n) { f32x4 x1 = acc[ai][0][m][n], x2 = acc[ai][1][m][n]; const int d = n * 16 + 4 * fq;
                        if (!isq && !sample) { *(f32x4*)(out + OUT_DK + (size_t)r * 512 + sh * 64 + d) = x1; *(f32x4*)(out + OUT_DK + (size_t)r * 512 + sh * 64 + 32 + d) = x2; }
                        if (sample) rope64(x1, x2, R64 + (size_t)((r - NP) & 1023) * 64, n, fq);
                        if (isq) { *(u32x2*)(QD + (size_t)r * 512 + sh * 64 + d) = pack4(x1 * QSCALE64); *(u32x2*)(QD + (size_t)r * 512 + sh * 64 + 32 + d) = pack4(x2 * QSCALE64); }
                        else { *(u32x2*)(KD + (size_t)kr * 512 + sh * 64 + d) = pack4(x1); *(u32x2*)(KD + (size_t)kr * 512 + sh * 64 + 32 + d) = pack4(x2); } } }
        } else {
#pragma unroll
            for (int ai = 0; ai < 2; ++ai)
#pragma unroll
                for (int m = 0; m < 4; ++m) { const int rt = ai * 128 + wr * 64 + m * 16 + fr, r = u.arow + rt, kr = kbase + rt;
#pragma unroll
                    for (int bj = 0; bj < 2; ++bj)
#pragma unroll
                        for (int n = 0; n < 2; ++n) { const int c = (u.pn - 6) * 256 + bj * 128 + wc * 32 + n * 16 + 4 * fq; const f32x4 v = acc[ai][bj][m][n];
                            if (!sample) *(f32x4*)(out + OUT_DV + (size_t)r * 512 + c) = v;
                            store_vt(VTD, c, kr, v); } }
        }
    }
};
struct EpiInO {
    static constexpr bool PERM = false, AFTER_DRAIN = false;
    bf16_t *QC, *QN, *KC, *KN, *VTC, *VTN; float* out; const float *qknw, *R64;
    __device__ __forceinline__ void operator()(const f32x4 (&acc)[2][2][4][2], const pg8::Unit& u, int wr, int wc, int fr, int fq) const {
        const bool sample = u.arow >= NP; const int kbase = krow_of(u.arow);
        if (u.pn < 3) {
            const bool isv = (u.pn == 2 && wc >= 2), isk = (u.pn == 2 && wc < 2); const int head = u.pn < 2 ? 4 * u.pn + wc : (wc & 1);
            const float* nw = qknw + (isk ? 64 : 0);
#pragma unroll
            for (int ai = 0; ai < 2; ++ai)
#pragma unroll
                for (int m = 0; m < 4; ++m) { const int rt = ai * 128 + wr * 64 + m * 16 + fr, r = u.arow + rt, kr = kbase + rt;
                    if (isv) {
#pragma unroll
                        for (int bj = 0; bj < 2; ++bj)
#pragma unroll
                            for (int n = 0; n < 2; ++n) { const int c = head * 64 + bj * 32 + n * 16 + 4 * fq; const f32x4 v = acc[ai][bj][m][n];
                                if (!sample) *(f32x4*)(out + OUT_GV + (size_t)r * 128 + c) = v;
                                store_vt(VTC, c, kr, v); }
                    } else {
                        float ss = ss4(acc[ai][0][m][0]) + ss4(acc[ai][0][m][1]) + ss4(acc[ai][1][m][0]) + ss4(acc[ai][1][m][1]);
                        ss += __shfl_xor(ss, 16); ss += __shfl_xor(ss, 32);
                        const float rstd = rsqrtf(ss * (1.f / 64.f) + EPS);
#pragma unroll
                        for (int n = 0; n < 2; ++n) { const int d = n * 16 + 4 * fq;
                            f32x4 x1 = acc[ai][0][m][n] * rstd * *(const f32x4*)(nw + d), x2 = acc[ai][1][m][n] * rstd * *(const f32x4*)(nw + 32 + d);
                            if (isk && !sample) { *(f32x4*)(out + OUT_GK + (size_t)r * 128 + head * 64 + d) = x1; *(f32x4*)(out + OUT_GK + (size_t)r * 128 + head * 64 + 32 + d) = x2; }
                            if (sample) rope64(x1, x2, R64 + (size_t)((r - NP) & 1023) * 64, n, fq);
                            if (isk) { *(u32x2*)(KC + (size_t)kr * 128 + head * 64 + d) = pack4(x1); *(u32x2*)(KC + (size_t)kr * 128 + head * 64 + 32 + d) = pack4(x2); }
                            else { *(u32x2*)(QC + (size_t)r * 512 + head * 64 + d) = pack4(x1 * QSCALE64); *(u32x2*)(QC + (size_t)r * 512 + head * 64 + 32 + d) = pack4(x2 * QSCALE64); } }
                    } }
        } else {
            const int kind = (u.pn - 3) >> 1;
#pragma unroll
            for (int ai = 0; ai < 2; ++ai)
#pragma unroll
                for (int m = 0; m < 4; ++m) { const int rt = ai * 128 + wr * 64 + m * 16 + fr, r = u.arow + rt, kr = kbase + rt;
#pragma unroll
                    for (int bj = 0; bj < 2; ++bj)
#pragma unroll
                        for (int n = 0; n < 2; ++n) { const int c = ((u.pn - 3) & 1) * 256 + bj * 128 + wc * 32 + n * 16 + 4 * fq; const f32x4 v = acc[ai][bj][m][n];
                            if (kind == 0) *(u32x2*)(QN + (size_t)r * 512 + c) = pack4(v * QSCALE64);
                            else if (kind == 1) { if (!sample) *(f32x4*)(out + OUT_NK + (size_t)r * 512 + c) = v; *(u32x2*)(KN + (size_t)kr * 512 + c) = pack4(v); }
                            else { if (!sample) *(f32x4*)(out + OUT_NV + (size_t)r * 512 + c) = v; store_vt(VTN, c, kr, v); } } }
        }
    }
};
struct EpiUQ {
    static constexpr bool PERM = false, AFTER_DRAIN = false;
    bf16_t* QA; const float *PSQ, *R32;
    __device__ __forceinline__ void operator()(const f32x4 (&acc)[2][2][4][2], const pg8::Unit& u, int wr, int wc, int fr, int fq) const {
        const bool sample = u.arow >= NP;
#pragma unroll
        for (int ai = 0; ai < 2; ++ai)
#pragma unroll
            for (int m = 0; m < 4; ++m) { const int rt = ai * 128 + wr * 64 + m * 16 + fr, r = u.arow + rt;
                const f32x4 ps = *(const f32x4*)(PSQ + (size_t)r * 4); const float rstd = rsqrtf((ps[0] + ps[1] + ps[2] + ps[3]) * (1.f / 256.f) + EPS) * QSCALE96;
#pragma unroll
                for (int bj = 0; bj < 2; ++bj) { const int blk = 8 * u.pn + 4 * bj + wc; f32x4 x1 = acc[ai][bj][m][0] * rstd, x2 = acc[ai][bj][m][1] * rstd;
                    if (sample && (blk % 3) == 2) { const float* tab = R32 + (size_t)((r - NP) & 1023) * 32; const f32x4 cs = *(const f32x4*)(tab + 4 * fq), sn = *(const f32x4*)(tab + 16 + 4 * fq);
                        const f32x4 a = x1 * cs - x2 * sn, b = x1 * sn + x2 * cs; x1 = a; x2 = b; }
                    *(u32x2*)(QA + (size_t)r * 768 + blk * 32 + 4 * fq) = pack4(x1); *(u32x2*)(QA + (size_t)r * 768 + blk * 32 + 16 + 4 * fq) = pack4(x2); } }
    }
};
struct EpiKV {
    static constexpr bool PERM = false, AFTER_DRAIN = false;
    bf16_t *KA, *VTA; const float* PSKV; float* out;
    __device__ __forceinline__ float row_rstd(int kr, bool ctx) const {
        if (ctx) return 1.f;
        const f32x4 ps = *(const f32x4*)(PSKV + (size_t)kr * 4); return rsqrtf((ps[0] + ps[1] + ps[2] + ps[3]) * (1.f / 128.f) + EPS);
    }
    __device__ __forceinline__ void operator()(const f32x4 (&acc)[2][2][4][2], const pg8::Unit& u, int wr, int wc, int fr, int fq) const {
        const bool ctx = u.pm >= 32 && ((u.pm - 32) % 5) == 4;
#pragma unroll
        for (int ai = 0; ai < 2; ++ai)
#pragma unroll
            for (int m = 0; m < 4; ++m) { const int rt = ai * 128 + wr * 64 + m * 16 + fr, kr = u.arow + rt; const float rstd = row_rstd(kr, ctx);
#pragma unroll
                for (int bj = 0; bj < 2; ++bj)
#pragma unroll
                    for (int n = 0; n < 2; ++n) { const int c = u.pn * 256 + bj * 128 + wc * 32 + n * 16 + 4 * fq; const f32x4 v = acc[ai][bj][m][n] * rstd;
                        if (u.pn < 2) *(u32x2*)(KA + (size_t)kr * 768 + (c >> 6) * 96 + (c & 63)) = pack4(v);
                        else store_vt(VTA, c - 512, kr, v); } }
    }
};

typedef short s16x4 __attribute__((ext_vector_type(4)));
__device__ __forceinline__ int crow(int r, int hi) { return (r & 3) + 8 * (r >> 2) + 4 * hi; }
__device__ __forceinline__ bf16x8 pack8(const f32x16& p, int b) {
    u32x4 w; w.x = cvt_pk_bf16(p[b], p[b + 1]); w.y = cvt_pk_bf16(p[b + 2], p[b + 3]); w.z = cvt_pk_bf16(p[b + 4], p[b + 5]); w.w = cvt_pk_bf16(p[b + 6], p[b + 7]);
    return __builtin_bit_cast(bf16x8, w);
}
template <int DQK, int KDIMS, int DV, int MODE>
__device__ __forceinline__ void attn_unit(LAS unsigned char* L, const bf16_t* __restrict__ Qp, int ldq, const bf16_t* __restrict__ Kp, int ldk, const bf16_t* __restrict__ VTp, int nkt, bf16_t* __restrict__ Op,
                                          float lam, const float* __restrict__ subln, const float* __restrict__ rpbh, int ub) {
    constexpr int PK = KDIMS * 2 + 16, PV = 136, KB = 64 * PK, VB = DV * PV, BUF = KB + VB;
    constexpr int KC8 = KDIMS / 8, KCH = 64 * KC8, VCH = DV * 8, NKL = (KCH + 511) / 512, NVL = (VCH + 511) / 512, NS = DQK / 16, NDT = DV / 32;
    const int tid = threadIdx.x, lane = tid & 63, wave = __builtin_amdgcn_readfirstlane(tid >> 6), r32 = lane & 31, hi = lane >> 5;
    const int comp = MODE == 1 ? (wave >> 2) : 0, qblk = MODE == 1 ? (wave & 3) : wave;
    int t_lo = 0, n_band = 0, gr = 0, rs = 0;
    if (MODE == 2) { const int g0 = 4 * ub; int lo = g0 - 4; lo = lo < 0 ? 0 : (lo > 8 ? 8 : lo); int hi_r = g0 + 3 - 4; hi_r = hi_r < 0 ? 0 : (hi_r > 8 ? 8 : hi_r); t_lo = lo; n_band = hi_r + 8 - lo;
        gr = g0 + (wave >> 1); rs = gr - 4; rs = rs < 0 ? 0 : (rs > 8 ? 8 : rs); nkt = n_band + 4; }
    LAS float* rpbs = (LAS float*)(L + 2 * BUF);
    if (MODE == 2) { for (int i = tid; i < 465; i += 512) rpbs[i] = rpbh[i] * LOG2E; }
    bf16x8 qf[NS];
    { const bf16_t* qrow = Qp + (size_t)(qblk * 32 + r32) * ldq + comp * 64 + hi * 8;
#pragma unroll
      for (int s = 0; s < NS; ++s) qf[s] = *(const bf16x8*)(qrow + 16 * s); }
    u32x4 kreg[NKL], vreg[NVL];
    auto tile_krow = [&](int t) -> int { return MODE == 2 ? (t < n_band ? (t_lo + t) * 64 : 1024 + (t - n_band) * 64) : t * 64; };
    auto gload = [&](int t) { const int kr0 = tile_krow(t);
#pragma unroll
        for (int i = 0; i < NKL; ++i) { const int ch = tid + 512 * i; if (NKL * 512 == KCH || ch < KCH) { const int row = ch / KC8, cc = ch % KC8; kreg[i] = *(const u32x4*)(Kp + (size_t)(kr0 + row) * ldk + cc * 8); } }
#pragma unroll
        for (int i = 0; i < NVL; ++i) { const int ch = tid + 512 * i; const int row = ch >> 3, cc = ch & 7; vreg[i] = *(const u32x4*)(VTp + (size_t)row * NKR + kr0 + cc * 8); } };
    auto lstore = [&](int buf) { LAS unsigned char* kb = L + buf * BUF; LAS unsigned char* vb = kb + KB;
#pragma unroll
        for (int i = 0; i < NKL; ++i) { const int ch = tid + 512 * i; if (NKL * 512 == KCH || ch < KCH) { const int row = ch / KC8, cc = ch % KC8; *(LAS u32x4*)(kb + row * PK + cc * 16) = kreg[i]; } }
#pragma unroll
        for (int i = 0; i < NVL; ++i) { const int ch = tid + 512 * i; const int row = ch >> 3, cc = ch & 7; LAS unsigned char* dst = vb + row * PV + cc * 16; *(LAS u32x2*)dst = (u32x2){vreg[i].x, vreg[i].y}; *(LAS u32x2*)(dst + 8) = (u32x2){vreg[i].z, vreg[i].w}; } };
    f32x16 o[NDT];
#pragma unroll
    for (int dt = 0; dt < NDT; ++dt)
#pragma unroll
        for (int r = 0; r < 16; ++r) o[dt][r] = 0.f;
    float m_run = -INFINITY, l_run = 0.f;
    gload(0); lstore(0);
    __syncthreads();
    for (int t = 0; t < nkt; ++t) {
        const int buf = t & 1;
        if (t + 1 < nkt) gload(t + 1);
        bool active = true; int drow = 0;
        if (MODE == 2 && t < n_band) { const int krw = t_lo + t; active = (krw >= rs) && (krw < rs + 8); drow = krw - gr + 7; }
        if (active) {
            LAS unsigned char* kb = L + buf * BUF; LAS unsigned char* vb = kb + KB;
            f32x16 p0, p1;
#pragma unroll
            for (int r = 0; r < 16; ++r) { p0[r] = 0.f; p1[r] = 0.f; }
            const LAS unsigned char* ka = kb + r32 * PK + (comp * 64 + hi * 8) * 2;
#pragma unroll
            for (int s = 0; s < NS; ++s) { const bf16x8 a0 = *(const LAS bf16x8*)(ka + s * 32), a1 = *(const LAS bf16x8*)(ka + 32 * PK + s * 32);
                p0 = __builtin_amdgcn_mfma_f32_32x32x16_bf16(a0, qf[s], p0, 0, 0, 0); p1 = __builtin_amdgcn_mfma_f32_32x32x16_bf16(a1, qf[s], p1, 0, 0, 0); }
            if (MODE == 2 && t < n_band) {
                const int qc = 32 * (wave & 1) + r32; int cs = qc - 8; cs = cs < 0 ? 0 : (cs > 48 ? 48 : cs);
                const LAS float* brow = rpbs + drow * 31;
#pragma unroll
                for (int r = 0; r < 16; ++r) { const int kc0 = crow(r, hi), kc1 = kc0 + 32;
                    int d0 = kc0 - qc + 15; d0 = d0 < 0 ? 0 : (d0 > 30 ? 30 : d0); int d1 = kc1 - qc + 15; d1 = d1 < 0 ? 0 : (d1 > 30 ? 30 : d1);
                    p0[r] = (kc0 >= cs && kc0 < cs + 16) ? p0[r] + brow[d0] : -INFINITY; p1[r] = (kc1 >= cs && kc1 < cs + 16) ? p1[r] + brow[d1] : -INFINITY; }
            }
            float mt = fmaxf(p0[0], p1[0]);
#pragma unroll
            for (int r = 1; r < 16; ++r) mt = fmaxf(mt, fmaxf(p0[r], p1[r]));
            mt = fmaxf(mt, __shfl_xor(mt, 32));
            const float m_new = fmaxf(m_run, mt), m_use = (m_new == -INFINITY) ? 0.f : m_new;
            if (__any(m_new > m_run)) { const float alpha = __builtin_amdgcn_exp2f(m_run - m_use); l_run *= alpha;
#pragma unroll
                for (int dt = 0; dt < NDT; ++dt)
#pragma unroll
                    for (int r = 0; r < 16; ++r) o[dt][r] *= alpha; }
            m_run = m_new;
            float ls = 0.f;
#pragma unroll
            for (int r = 0; r < 16; ++r) { p0[r] = __builtin_amdgcn_exp2f(p0[r] - m_use); p1[r] = __builtin_amdgcn_exp2f(p1[r] - m_use); ls += p0[r] + p1[r]; }
            l_run += ls;
            const bf16x8 pb0 = pack8(p0, 0), pb1 = pack8(p0, 8), pb2 = pack8(p1, 0), pb3 = pack8(p1, 8);
            const LAS unsigned char* va = vb + r32 * PV + hi * 8;
#pragma unroll
            for (int dt = 0; dt < NDT; ++dt) { const LAS unsigned char* vd = va + dt * 32 * PV;
#pragma unroll
                for (int s = 0; s < 4; ++s) { const s16x4 lo = *(const LAS s16x4*)(vd + s * 32), hh = *(const LAS s16x4*)(vd + s * 32 + 16);
                    const bf16x8 a = (bf16x8){lo[0], lo[1], lo[2], lo[3], hh[0], hh[1], hh[2], hh[3]};
                    o[dt] = __builtin_amdgcn_mfma_f32_32x32x16_bf16(a, s == 0 ? pb0 : (s == 1 ? pb1 : (s == 2 ? pb2 : pb3)), o[dt], 0, 0, 0); } }
        }
        if (t + 1 < nkt) lstore(buf ^ 1);
        __syncthreads();
    }
    const float l_tot = l_run + __shfl_xor(l_run, 32);
    const float inv = 1.f / l_tot;
    if (MODE == 1) {
        LAS float* xch = (LAS float*)L;
        if (comp == 1) {
#pragma unroll
            for (int dt = 0; dt < NDT; ++dt)
#pragma unroll
                for (int r = 0; r < 16; ++r) xch[(qblk * 128 + dt * 32 + crow(r, hi)) * 32 + r32] = o[dt][r] * inv;
        }
        __syncthreads();
        if (comp == 0) {
            float ss = 0.f;
#pragma unroll
            for (int dt = 0; dt < NDT; ++dt)
#pragma unroll
                for (int r = 0; r < 16; ++r) { const float v = o[dt][r] * inv - lam * xch[(qblk * 128 + dt * 32 + crow(r, hi)) * 32 + r32]; o[dt][r] = v; ss += v * v; }
            ss += __shfl_xor(ss, 32);
            const float rstd = rsqrtf(ss * (1.f / 128.f) + EPS) * 0.8f;
#pragma unroll
            for (int dt = 0; dt < NDT; ++dt)
#pragma unroll
                for (int g = 0; g < 4; ++g) { const int d = dt * 32 + 8 * g + 4 * hi; const f32x4 w = *(const f32x4*)(subln + d);
                    const f32x4 v = {o[dt][4 * g] * rstd * w[0], o[dt][4 * g + 1] * rstd * w[1], o[dt][4 * g + 2] * rstd * w[2], o[dt][4 * g + 3] * rstd * w[3]};
                    *(u32x2*)(Op + (size_t)(qblk * 32 + r32) * D + d) = pack4(v); }
        }
        __syncthreads();
    } else {
#pragma unroll
        for (int dt = 0; dt < NDT; ++dt)
#pragma unroll
            for (int g = 0; g < 4; ++g) { const int d = dt * 32 + 8 * g + 4 * hi;
                const f32x4 v = {o[dt][4 * g] * inv, o[dt][4 * g + 1] * inv, o[dt][4 * g + 2] * inv, o[dt][4 * g + 3] * inv};
                *(u32x2*)(Op + (size_t)(qblk * 32 + r32) * D + d) = pack4(v); }
    }
}
template <int LAYER> __device__ __forceinline__ void phase_attn(const FastP& p, LAS unsigned char* L) {
    unsigned char* ws = p.ws; bf16_t* O = (bf16_t*)(ws + WS_O);
    for (int c0 = blockIdx.x; c0 < 256; c0 += gridDim.x) {
        int c = c0; asm volatile("" : "+s"(c));
        if (LAYER == 0) {
            const bf16_t *QA = (const bf16_t*)(ws + WS_QA), *QD = (const bf16_t*)(ws + WS_QD), *KA = (const bf16_t*)(ws + WS_KA), *KD = (const bf16_t*)(ws + WS_KD), *VTA = (const bf16_t*)(ws + WS_VTA), *VTD = (const bf16_t*)(ws + WS_VTD);
            const float lam = *(const float*)(ws + WS_LAM);
            if (c < 128) { const int b = c >> 5, h = (c >> 3) & 3, qt = c & 7; const int q0 = NP + b * 1024 + qt * 128, k0 = NP + b * 1280;
                attn_unit<64, 128, 128, 1>(L, QD + (size_t)q0 * 512 + h * 128, 512, KD + (size_t)k0 * 512 + h * 128, 512, VTD + (size_t)(h * 128) * NKR + k0, 20, O + (size_t)q0 * D + 512 + h * 128, lam, p.diff_subln_w, nullptr, 0); }
            else { const int cc = c - 128, b = cc >> 5, h = (cc >> 2) & 7, qt = cc & 3; const int q0 = NP + b * 1024 + qt * 256, k0 = NP + b * 1280;
                attn_unit<96, 96, 64, 0>(L, QA + (size_t)q0 * 768 + h * 96, 768, KA + (size_t)k0 * 768 + h * 96, 768, VTA + (size_t)(h * 64) * NKR + k0, 20, O + (size_t)q0 * D + h * 64, 0.f, nullptr, nullptr, 0); }
            asm volatile("" : "+s"(c));
            { const int b = c >> 3, h = (c >> 1) & 3, qt = c & 1; const int q0 = b * 256 + qt * 128, k0 = b * 256;
                attn_unit<64, 128, 128, 1>(L, QD + (size_t)q0 * 512 + h * 128, 512, KD + (size_t)k0 * 512 + h * 128, 512, VTD + (size_t)(h * 128) * NKR + k0, 4, O + (size_t)q0 * D + 512 + h * 128, lam, p.diff_subln_w, nullptr, 0); }
            asm volatile("" : "+s"(c));
            { const int b = c >> 3, h = c & 7; const int q0 = b * 256;
                attn_unit<96, 96, 64, 0>(L, QA + (size_t)q0 * 768 + h * 96, 768, KA + (size_t)q0 * 768 + h * 96, 768, VTA + (size_t)(h * 64) * NKR + q0, 4, O + (size_t)q0 * D + h * 64, 0.f, nullptr, nullptr, 0); }
        } else {
            const bf16_t *QC = (const bf16_t*)(ws + WS_QC), *QN = (const bf16_t*)(ws + WS_QN), *KC = (const bf16_t*)(ws + WS_KC), *KN = (const bf16_t*)(ws + WS_KN), *VTC = (const bf16_t*)(ws + WS_VTC), *VTN = (const bf16_t*)(ws + WS_VTN);
            if (c < 128) { const int b = c >> 5, h = (c >> 2) & 7, qt = c & 3; const int q0 = NP + b * 1024 + qt * 256, k0 = NP + b * 1280;
                attn_unit<64, 64, 64, 0>(L, QC + (size_t)q0 * 512 + h * 64, 512, KC + (size_t)k0 * 128 + (h >> 2) * 64, 128, VTC + (size_t)((h >> 2) * 64) * NKR + k0, 20, O + (size_t)q0 * D + h * 64, 0.f, nullptr, nullptr, 0); }
            else { const int cc = c - 128, b = cc >> 5, h = (cc >> 2) & 7, ub = cc & 3; const int q0 = NP + b * 1024 + ub * 256, k0 = NP + b * 1280;
                attn_unit<64, 64, 64, 2>(L, QN + (size_t)q0 * 512 + h * 64, 512, KN + (size_t)k0 * 512 + h * 64, 512, VTN + (size_t)(h * 64) * NKR + k0, 0, O + (size_t)q0 * D + 512 + h * 64, 0.f, nullptr, p.na_rpb + h * 465, ub); }
            asm volatile("" : "+s"(c));
            { const int b = c >> 3, h = c & 7; const int q0 = b * 256;
                attn_unit<64, 64, 64, 0>(L, QC + (size_t)q0 * 512 + h * 64, 512, KC + (size_t)q0 * 128 + (h >> 2) * 64, 128, VTC + (size_t)((h >> 2) * 64) * NKR + q0, 4, O + (size_t)q0 * D + h * 64, 0.f, nullptr, nullptr, 0);
              asm volatile("" : "+s"(c));
              attn_unit<64, 64, 64, 0>(L, QN + (size_t)q0 * 512 + h * 64, 512, KN + (size_t)q0 * 512 + h * 64, 512, VTN + (size_t)(h * 64) * NKR + q0, 4, O + (size_t)q0 * D + 512 + h * 64, 0.f, nullptr, nullptr, 0); }
        }
    }
}

#define FAST_KERNEL_HEAD extern __shared__ __attribute__((aligned(16))) unsigned char lds_[]; LAS unsigned char* L = (LAS unsigned char*)lds_; \
    const int tid = threadIdx.x, lane = tid & 63, wave = tid >> 6, gw = blockIdx.x * 8 + wave, NGW = gridDim.x * 8; (void)lane; (void)gw; (void)NGW; (void)L;
__device__ __forceinline__ const float* modl(const FastP& p, int l) { return (const float*)(p.ws + WS_MOD) + (size_t)l * 5 * 6144; }

__device__ __forceinline__ void phase_p0a(const FastP& p, LAS unsigned char* L, int tid, int lane, int wave, int gw, int NGW) {
    mods_phase(p, L, tid, blockIdx.x, gridDim.x);
    __syncthreads();
    conv_all_weights(p, (LAS float*)(L + wave * 16384), lane, gw, NGW);
    misc_prologue(p, blockIdx.x * 512 + tid, gridDim.x * 512);
}
__device__ __forceinline__ void phase_p0b(const FastP& p, int lane, int gw, int NGW) {
    row_phase<false, true>(p.x_prompt, p.x_sample, p.out, nullptr, nullptr, nullptr, 0, p.norm_w, modl(p, 0), 0, 1, (bf16_t*)(p.ws + WS_XN), lane, gw, NGW);
}
__device__ __forceinline__ void phase_in_even(const FastP& p, LAS unsigned char* L) {
    pg8::Gemm g{(const bf16_t*)(p.ws + WS_XN), (const bf16_t*)(p.ws + WS_WIE), NR, 2048, 1024};
    pg8::StaticOrder S; S.init(NR, 2048, gridDim.x, blockIdx.x);
    EpiInE E{(bf16_t*)(p.ws + WS_CQ), (bf16_t*)(p.ws + WS_CKV), (bf16_t*)(p.ws + WS_KA), (bf16_t*)(p.ws + WS_QD), (bf16_t*)(p.ws + WS_KD), (bf16_t*)(p.ws + WS_VTD), (float*)(p.ws + WS_PSQ), (float*)(p.ws + WS_PSKV),
             p.out, p.q_norm_w, p.kv_norm_w, (const float*)(p.ws + WS_ROPE64), (const float*)(p.ws + WS_ROPE32)};
    pg8::gemm_phase<EpiInE, pg8::StaticOrder, true, true>(L, g, S, E);
}
__device__ __forceinline__ void phase_uqkv(const FastP& p, LAS unsigned char* L) {
    int k256 = 256; asm volatile("" : "+s"(k256));
    { pg8::Gemm g{(const bf16_t*)(p.ws + WS_CQ), (const bf16_t*)(p.ws + WS_WUQ), NR, 768, k256};
      pg8::StaticOrder S; S.init(NR, 768, gridDim.x, blockIdx.x);
      EpiUQ E{(bf16_t*)(p.ws + WS_QA), (const float*)(p.ws + WS_PSQ), (const float*)(p.ws + WS_ROPE32)};
      pg8::gemm_phase<EpiUQ, pg8::StaticOrder, true, true>(L, g, S, E); }
    { pg8::Gemm g{(const bf16_t*)(p.ws + WS_CKV), (const bf16_t*)(p.ws + WS_WKV), NKR, 1024, k256};
      pg8::StaticOrder S; S.init(NKR, 1024, gridDim.x, (blockIdx.x + 144) % gridDim.x);
      EpiKV E{(bf16_t*)(p.ws + WS_KA), (bf16_t*)(p.ws + WS_VTA), (const float*)(p.ws + WS_PSKV), p.out};
      pg8::gemm_phase<EpiKV, pg8::StaticOrder, true, true>(L, g, S, E); }
}
__device__ __forceinline__ void phase_in_odd(const FastP& p, LAS unsigned char* L, int tid) {
    ctx_odd(p, blockIdx.x * 512 + tid, gridDim.x * 512);
    pg8::Gemm g{(const bf16_t*)(p.ws + WS_XN), (const bf16_t*)(p.ws + WS_WIO), NR, 2304, 1024};
    pg8::StaticOrder S; S.init(NR, 2304, gridDim.x, blockIdx.x);
    EpiInO E{(bf16_t*)(p.ws + WS_QC), (bf16_t*)(p.ws + WS_QN), (bf16_t*)(p.ws + WS_KC), (bf16_t*)(p.ws + WS_KN), (bf16_t*)(p.ws + WS_VTC), (bf16_t*)(p.ws + WS_VTN), p.out, p.qk_norm_w, (const float*)(p.ws + WS_ROPE64)};
    pg8::gemm_phase<EpiInO, pg8::StaticOrder, true, true>(L, g, S, E);
}
__device__ __forceinline__ void phase_wout(const FastP& p, LAS unsigned char* L, int l) {
    pg8::Gemm g{(const bf16_t*)(p.ws + WS_O), (const bf16_t*)(p.ws + (l == 0 ? WS_WOE : WS_WOO)), NR, 1024, 1024};
    pg8::StaticOrder S; S.init(NR, 1024, gridDim.x, blockIdx.x);
    EpiF32 E{(float*)(p.ws + WS_Y), 1024};
    pg8::gemm_phase<EpiF32, pg8::StaticOrder, true, true>(L, g, S, E);
}
__device__ __forceinline__ void phase_row1(const FastP& p, int l, int lane, int gw, int NGW) {
    const float* nw = p.norm_w + (size_t)l * 4 * D;
    if (l == 0) row_phase<true, true, true>(p.out, p.out + (size_t)NP * D, p.out, (const float*)(p.ws + WS_Y), nw + D, modl(p, l), 2, nw + 2 * D, modl(p, l), 3, 4, (bf16_t*)(p.ws + WS_XN), lane, gw, NGW, (const float*)(p.ws + WS_PSKV));
    else row_phase<true, true>(p.out, p.out + (size_t)NP * D, p.out, (const float*)(p.ws + WS_Y), nw + D, modl(p, l), 2, nw + 2 * D, modl(p, l), 3, 4, (bf16_t*)(p.ws + WS_XN), lane, gw, NGW);
}
__device__ __forceinline__ void phase_up(const FastP& p, LAS unsigned char* L, int l) {
    pg8::Gemm g{(const bf16_t*)(p.ws + WS_XN), (const bf16_t*)(p.ws + WS_WUP) + (size_t)l * 5632 * 1024, NR, 5632, 1024};
    UpOrder S; S.init(gridDim.x, blockIdx.x);
    EpiUpConv E{(bf16_t*)(p.ws + WS_G), p.conv_w + (size_t)l * 3 * 5632, p.conv_b + (size_t)l * 5632, (LAS f32x4*)(L + EX_OFF)};
    pg8::gemm_phase<EpiUpConv, UpOrder, true, true>(L, g, S, E);
}
__device__ __forceinline__ void phase_down(const FastP& p, LAS unsigned char* L, int l) {
    pg8::Gemm g{(const bf16_t*)(p.ws + WS_G), (const bf16_t*)(p.ws + WS_WDN) + (size_t)l * 1024 * 2816, NR, 1024, 2816};
    pg8::StaticOrder S; S.init(NR, 1024, gridDim.x, blockIdx.x);
    EpiF32 E{(float*)(p.ws + WS_Y), 1024};
    pg8::gemm_phase<EpiF32, pg8::StaticOrder, true, true>(L, g, S, E);
}
__device__ __forceinline__ void phase_row2(const FastP& p, int l, int lane, int gw, int NGW) {
    const float* nw = p.norm_w + (size_t)l * 4 * D;
    if (l == 0) row_phase<true, true>(p.out, p.out + (size_t)NP * D, p.out, (const float*)(p.ws + WS_Y), nw + 3 * D, modl(p, 0), 5, p.norm_w + 4 * D, modl(p, 1), 0, 1, (bf16_t*)(p.ws + WS_XN), lane, gw, NGW);
    else row_phase<true, false>(p.out, p.out + (size_t)NP * D, p.out, (const float*)(p.ws + WS_Y), nw + 3 * D, modl(p, 1), 5, nullptr, nullptr, 0, 0, nullptr, lane, gw, NGW);
}
template <int PH> __global__ void __launch_bounds__(512, 2) k_phase(FastP p, int l) {
    FAST_KERNEL_HEAD
    if (PH == 0) phase_p0a(p, L, tid, lane, wave, gw, NGW);
    if (PH == 1) phase_p0b(p, lane, gw, NGW);
    if (PH == 2) { if (l == 0) phase_in_even(p, L); else phase_in_odd(p, L, tid); }
    if (PH == 3) phase_uqkv(p, L);
    if (PH == 4) phase_attn<0>(p, L);
    if (PH == 40) phase_attn<1>(p, L);
    if (PH == 5) phase_wout(p, L, l);
    if (PH == 6) phase_row1(p, l, lane, gw, NGW);
    if (PH == 7) phase_up(p, L, l);
    if (PH == 8) phase_down(p, L, l);
    if (PH == 9) phase_row2(p, l, lane, gw, NGW);
}

template <int PH> static void launch_phase(hipStream_t st, const FastP& p, int l) {
    static bool done = false;
    if (!done) { done = true; (void)hipFuncSetAttribute((const void*)k_phase<PH>, hipFuncAttributeMaxDynamicSharedMemorySize, FAST_LDS_BYTES); }
    hipLaunchKernelGGL(k_phase<PH>, dim3(256), dim3(512), FAST_LDS_BYTES, st, p, l);
}
extern "C" void kernel_launch(void* const* d_in, const int* in_sizes, int n_in, void* d_out, int out_size, void* d_ws, size_t ws_size, hipStream_t stream) {
    if (n_in != 32 || (size_t)out_size != OUT_END || ws_size < WS_FAST_END) { fprintf(stderr, "kernel_launch: bad sizes\n"); return; }
    FastP p; memset(&p, 0, sizeof p);
    const float** pp = (const float**)&p;
    for (int i = 0; i < 32; ++i) pp[i] = (const float*)d_in[i];
    p.out = (float*)d_out; p.ws = (unsigned char*)d_ws;
    launch_phase<0>(stream, p, 0);
    launch_phase<1>(stream, p, 0);
    for (int l = 0; l < 2; ++l) {
        launch_phase<2>(stream, p, l);
        if (l == 0) launch_phase<3>(stream, p, l);
        if (l == 0) launch_phase<4>(stream, p, l); else launch_phase<40>(stream, p, l);
        launch_phase<5>(stream, p, l);
        launch_phase<6>(stream, p, l);
        launch_phase<7>(stream, p, l);
        launch_phase<8>(stream, p, l);
        launch_phase<9>(stream, p, l);
    }
}
```
